# Optimizing an MI355X kernel written in HIP

```python
import math
import jax, jax.numpy as jnp
from jax import lax
import numpy as np


D_MODEL = 1024
BATCH = 8
SEQ = 2048
DEPTH = 4

GRID_W = 64
CTX_LEN = 256
HEAD_DIM = 64
N_BRANCH = 3
N_MOD = 9
RMS_EPS = 1e-6

HY_WIDTH = D_MODEL // 2
HY_ORDER = 2
HY_EMB = 33
HY_BANDS = (HY_EMB - 1) // 2
HY_FFN = 64
HY_FAST_DECAY = 0.3
HY_SLOW_DECAY = 1.5
HY_TARGET = 1e-2
HY_FILTER_GAIN = 0.05
HY_COLS = (HY_ORDER + 1) * HY_WIDTH

SWA_HEADS = D_MODEL // 128
SWA_KV_HEADS = SWA_HEADS // 4
SWA_WINDOW = 128
SWA_BLOCK = 128
ROPE_BASE = 10000.0
SWA_COLS = (SWA_HEADS + 2 * SWA_KV_HEADS) * HEAD_DIM

NA_HEADS = D_MODEL // 128
NA_MAX_ROWS = 8
NA_COLS = 16
NA_COL_BLOCK = 16
NA_COL_SPAN = 2 * NA_COLS
NA_TOTAL_COLS = 3 * NA_HEADS * HEAD_DIM

BRANCH_WIDTH = HY_WIDTH
GATE_COLS = N_BRANCH * D_MODEL
IN_COLS = HY_COLS + SWA_COLS + NA_TOTAL_COLS + GATE_COLS
IN_SPLITS = [HY_COLS, HY_COLS + SWA_COLS, HY_COLS + SWA_COLS + NA_TOTAL_COLS]

FFN_HIDDEN = 256 * ((8 * D_MODEL // 3 + 255) // 256)

kernel_name = 'hybrid_hyena_swa_natten_macaron_dit'


def rms_norm(x, gain):
    xf = x.astype(jnp.float32)
    y = xf * lax.rsqrt(jnp.mean(xf * xf, axis=-1, keepdims=True) + RMS_EPS)
    return (y * gain.astype(jnp.float32)).astype(x.dtype)


def modulate(h, shift, scale):
    return h * (1.0 + scale) + shift


def swiglu(h, w_gate, w_up, w_down):
    return (jax.nn.silu(h @ w_gate) * (h @ w_up)) @ w_down


def ffn_half_step(x, mod3, gain, w_gate, w_up, w_down):
    shift, scale, gate = mod3
    h = modulate(rms_norm(x, gain), shift, scale)
    return x + 0.5 * gate * swiglu(h, w_gate, w_up, w_down)


def short_conv3(u, w, b):
    up = jnp.pad(u, ((0, 0), (1, 1), (0, 0)))
    return w[0] * up[:, :-2] + w[1] * up[:, 1:-1] + w[2] * up[:, 2:] + b


def hyena_filters(length, w0, b0, w1, b1, w2, b2, w_out, freq):
    t = jnp.linspace(0.0, 1.0, length, dtype=jnp.float32)[:, None]
    w = (2.0 * math.pi / length) * jnp.arange(length, dtype=jnp.float32)[:, None]
    f = jnp.linspace(1e-4, HY_BANDS - 1, HY_BANDS, dtype=jnp.float32)[None, :]
    z = jnp.concatenate([t, jnp.cos(f * w), -jnp.sin(f * w)], axis=-1)
    a = jnp.sin(freq * (z @ w0 + b0))
    a = jnp.sin(freq * (a @ w1 + b1))
    a = jnp.sin(freq * (a @ w2 + b2))
    h = (a @ w_out).reshape(length, HY_ORDER, 2, HY_WIDTH)
    max_decay = math.log(HY_TARGET) / HY_FAST_DECAY
    min_decay = math.log(HY_TARGET) / HY_SLOW_DECAY
    deltas = jnp.abs(jnp.linspace(min_decay, max_decay, HY_WIDTH, dtype=jnp.float32))
    window = jnp.exp(-t * deltas[None, :])
    return h * window[:, None, None, :]


def two_sided_long_conv(u, h_pos, h_neg, bias):
    length = u.shape[1]
    k = jnp.concatenate([h_pos, jnp.zeros_like(h_pos[:1]), h_neg[:0:-1]], axis=0).astype(jnp.float32)
    uf = u.astype(jnp.float32)
    n = 2 * length
    y = jnp.fft.irfft(jnp.fft.rfft(uf, n=n, axis=1) * jnp.fft.rfft(k, n=n, axis=0)[None], n=n, axis=1)[:, :length]
    return (y + uf * bias.astype(jnp.float32)).astype(u.dtype)


def hyena_branch(z, short_w, short_b, filter_params, bias):
    length = z.shape[1]
    z = short_conv3(z, short_w, short_b)
    v, x1, x2 = jnp.split(z, HY_ORDER + 1, axis=-1)
    h = hyena_filters(length, *filter_params)
    y = x1 * two_sided_long_conv(v, h[:, 0, 0], h[:, 0, 1], bias[0])
    return x2 * two_sided_long_conv(y, h[:, 1, 0], h[:, 1, 1], bias[1])


def split_qkv(z, n_q, n_kv):
    q, k, v = jnp.split(z, [n_q * HEAD_DIM, (n_q + n_kv) * HEAD_DIM], axis=-1)
    lead = z.shape[:-1]
    return (q.reshape(lead + (n_q, HEAD_DIM)), k.reshape(lead + (n_kv, HEAD_DIM)),
            v.reshape(lead + (n_kv, HEAD_DIM)))


def axial_rope_tables(length):
    pos = jnp.arange(length)
    row = (pos // GRID_W).astype(jnp.float32)
    col = (pos % GRID_W).astype(jnp.float32)
    half = HEAD_DIM // 2
    inv = 1.0 / (ROPE_BASE ** (jnp.arange(0, half, 2, dtype=jnp.float32) / half))
    ang_r = row[:, None] * inv[None, :]
    ang_c = col[:, None] * inv[None, :]
    return jnp.cos(ang_r), jnp.sin(ang_r), jnp.cos(ang_c), jnp.sin(ang_c)


def rotate_half_pairs(x, cos, sin):
    x1, x2 = jnp.split(x, 2, axis=-1)
    c = cos[:, None, :]
    s = sin[:, None, :]
    return jnp.concatenate([x1 * c - x2 * s, x2 * c + x1 * s], axis=-1)


def apply_axial_rope(x, tabs):
    cr, sr, cc, sc = tabs
    xr, xcol = jnp.split(x, 2, axis=-1)
    return jnp.concatenate([rotate_half_pairs(xr, cr, sr), rotate_half_pairs(xcol, cc, sc)], axis=-1).astype(x.dtype)


def window_gqa(q, k, v, kc, vc, sink):
    b, length, nh, hd = q.shape
    nkv = k.shape[2]
    g = nh // nkv
    nb = length // SWA_BLOCK
    scale = hd ** -0.5
    qb = q.reshape(b, nb, SWA_BLOCK, nkv, g, hd)
    pad = ((0, 0), (SWA_BLOCK, SWA_BLOCK), (0, 0), (0, 0))
    kp = jnp.pad(k, pad).reshape(b, nb + 2, SWA_BLOCK, nkv, hd)
    vp = jnp.pad(v, pad).reshape(b, nb + 2, SWA_BLOCK, nkv, hd)
    idx = jnp.arange(nb)[:, None] + jnp.arange(3)[None, :]
    span = 3 * SWA_BLOCK
    kb = kp[:, idx].reshape(b, nb, span, nkv, hd)
    vb = vp[:, idx].reshape(b, nb, span, nkv, hd)
    qpos = jnp.arange(length).reshape(nb, SWA_BLOCK)
    kpos = ((idx - 1)[..., None] * SWA_BLOCK + jnp.arange(SWA_BLOCK)).reshape(nb, span)
    valid = ((kpos[:, None, :] >= 0) & (kpos[:, None, :] < length)
             & (jnp.abs(qpos[:, :, None] - kpos[:, None, :]) <= SWA_WINDOW))
    s_loc = jnp.einsum('bnqkgd,bnskd->bnkgqs', qb, kb).astype(jnp.float32) * scale
    s_loc = jnp.where(valid[None, :, None, None], s_loc, -jnp.inf)
    s_ctx = jnp.einsum('bnqkgd,bckd->bnkgqc', qb, kc).astype(jnp.float32) * scale
    s_sink = jnp.broadcast_to(sink.reshape(nkv, g, 1, 1).astype(jnp.float32), s_loc.shape[:-1] + (1,))
    p = jax.nn.softmax(jnp.concatenate([s_loc, s_ctx, s_sink], axis=-1), axis=-1)
    n_ctx = kc.shape[1]
    p_loc = p[..., :span].astype(v.dtype)
    p_ctx = p[..., span:span + n_ctx].astype(v.dtype)
    o = jnp.einsum('bnkgqs,bnskd->bnqkgd', p_loc, vb) + jnp.einsum('bnkgqc,bckd->bnqkgd', p_ctx, vc)
    return o.reshape(b, length, nh * hd)


def neighbourhood_attention(q, k, v, kc, vc, rpb):
    b, length, nh, hd = q.shape
    rows = length // GRID_W
    wr = min(NA_MAX_ROWS, rows)
    ncb = GRID_W // NA_COL_BLOCK
    scale = hd ** -0.5
    qg = q.reshape(b, rows, ncb, NA_COL_BLOCK, nh, hd)
    kg = k.reshape(b, rows, GRID_W, nh, hd)
    vg = v.reshape(b, rows, GRID_W, nh, hd)
    r = jnp.arange(rows)
    row_idx = jnp.clip(r - wr // 2, 0, rows - wr)[:, None] + jnp.arange(wr)[None, :]
    j = jnp.arange(ncb)
    col_idx = (jnp.clip(j * NA_COL_BLOCK - NA_COLS // 2, 0, GRID_W - NA_COL_SPAN)[:, None]
               + jnp.arange(NA_COL_SPAN)[None, :])
    ri = row_idx[:, None, :, None]
    ci = col_idx[None, :, None, :]
    kn = kg[:, ri, ci]
    vn = vg[:, ri, ci]
    s_loc = jnp.einsum('brjqhd,brjwshd->brjhqws', qg, kn).astype(jnp.float32) * scale
    qcol = j[:, None] * NA_COL_BLOCK + jnp.arange(NA_COL_BLOCK)[None, :]
    cstart = jnp.clip(qcol - NA_COLS // 2, 0, GRID_W - NA_COLS)
    kcol = col_idx[:, None, :]
    valid = (kcol >= cstart[..., None]) & (kcol < cstart[..., None] + NA_COLS)
    dr = row_idx - r[:, None] + (NA_MAX_ROWS - 1)
    dc = jnp.clip(kcol - qcol[..., None], -(NA_COLS - 1), NA_COLS - 1) + (NA_COLS - 1)
    bias = rpb[:, dr[:, None, None, :, None], dc[None, :, :, None, :]]
    bias = jnp.moveaxis(bias, 0, 2).astype(jnp.float32)
    s_loc = jnp.where(valid[:, None, :, None, :], s_loc + bias, -jnp.inf)
    n_loc = wr * NA_COL_SPAN
    s_loc = s_loc.reshape(b, rows, ncb, nh, NA_COL_BLOCK, n_loc)
    s_ctx = jnp.einsum('brjqhd,bchd->brjhqc', qg, kc).astype(jnp.float32) * scale
    p = jax.nn.softmax(jnp.concatenate([s_loc, s_ctx], axis=-1), axis=-1)
    p_loc = p[..., :n_loc].reshape(b, rows, ncb, nh, NA_COL_BLOCK, wr, NA_COL_SPAN).astype(v.dtype)
    p_ctx = p[..., n_loc:].astype(v.dtype)
    o = jnp.einsum('brjhqws,brjwshd->brjqhd', p_loc, vn) + jnp.einsum('brjhqc,bchd->brjqhd', p_ctx, vc)
    return o.reshape(b, length, nh * hd)


def context_attention(q, k, v, sink):
    b, n, nh, hd = q.shape
    nkv = k.shape[2]
    g = nh // nkv
    qg = q.reshape(b, n, nkv, g, hd)
    s = jnp.einsum('bqkgd,bckd->bkgqc', qg, k).astype(jnp.float32) * hd ** -0.5
    if sink is not None:
        sk = jnp.broadcast_to(sink.reshape(nkv, g, 1, 1).astype(jnp.float32), s.shape[:-1] + (1,))
        s = jnp.concatenate([s, sk], axis=-1)
    p = jax.nn.softmax(s, axis=-1)[..., :k.shape[1]].astype(v.dtype)
    o = jnp.einsum('bkgqc,bckd->bqkgd', p, v)
    return o.reshape(b, n, nh * hd)


def merge_branches(outs, z_gate, w_branch, w_out):
    proj = jnp.einsum('...ne,ned->...nd', jnp.stack(outs, axis=-2), w_branch)
    gates = jax.nn.sigmoid(z_gate.reshape(z_gate.shape[:-1] + (N_BRANCH, D_MODEL)))
    return jnp.sum(gates * proj, axis=-2) @ w_out


def setup_inputs(seed: int = 0) -> dict:
    key = jax.random.key(seed)
    ks = jax.random.split(key, 32)

    def nrm(k, shape, scale=1.0):
        return jax.random.normal(k, shape, jnp.float32) * scale

    return {
        'x': nrm(ks[0], (BATCH, SEQ, D_MODEL)),
        'c': nrm(ks[1], (BATCH, D_MODEL)),
        'ctx': nrm(ks[2], (BATCH, CTX_LEN, D_MODEL)),
        'c_ctx': nrm(ks[3], (D_MODEL,)),
        'w_ada': nrm(ks[4], (DEPTH, D_MODEL, N_MOD * D_MODEL), 0.5 * D_MODEL ** -0.5),
        'b_ada': nrm(ks[5], (DEPTH, N_MOD * D_MODEL), 0.02),
        'norm_g': 1.0 + nrm(ks[6], (DEPTH, 3, D_MODEL), 0.02),
        'ffn_w_gate': nrm(ks[7], (DEPTH, 2, D_MODEL, FFN_HIDDEN), D_MODEL ** -0.5),
        'ffn_w_up': nrm(ks[8], (DEPTH, 2, D_MODEL, FFN_HIDDEN), D_MODEL ** -0.5),
        'ffn_w_down': nrm(ks[9], (DEPTH, 2, FFN_HIDDEN, D_MODEL), FFN_HIDDEN ** -0.5),
        'w_in': nrm(ks[10], (DEPTH, D_MODEL, IN_COLS), D_MODEL ** -0.5),
        'hy_short_w': nrm(ks[11], (DEPTH, 3, HY_COLS), 3 ** -0.5),
        'hy_short_b': nrm(ks[12], (DEPTH, HY_COLS), 0.02),
        'hy_pe_w0': nrm(ks[13], (DEPTH, HY_EMB, HY_FFN), HY_EMB ** -0.5),
        'hy_pe_b0': nrm(ks[14], (DEPTH, HY_FFN), 0.02),
        'hy_pe_w1': nrm(ks[15], (DEPTH, HY_FFN, HY_FFN), HY_FFN ** -0.5),
        'hy_pe_b1': nrm(ks[16], (DEPTH, HY_FFN), 0.02),
        'hy_pe_w2': nrm(ks[17], (DEPTH, HY_FFN, HY_FFN), HY_FFN ** -0.5),
        'hy_pe_b2': nrm(ks[18], (DEPTH, HY_FFN), 0.02),
        'hy_pe_wout': nrm(ks[19], (DEPTH, HY_FFN, HY_ORDER * 2 * HY_WIDTH), HY_FILTER_GAIN * HY_FFN ** -0.5),
        'hy_sin_freq': 1.0 + nrm(ks[20], (DEPTH, HY_FFN), 0.02),
        'hy_bias': nrm(ks[21], (DEPTH, HY_ORDER, HY_WIDTH), 0.1),
        'swa_q_gain': 1.0 + nrm(ks[22], (DEPTH, HEAD_DIM), 0.02),
        'swa_k_gain': 1.0 + nrm(ks[23], (DEPTH, HEAD_DIM), 0.02),
        'swa_sink': nrm(ks[24], (DEPTH, SWA_HEADS), 0.5),
        'na_q_gain': 1.0 + nrm(ks[25], (DEPTH, HEAD_DIM), 0.02),
        'na_k_gain': 1.0 + nrm(ks[26], (DEPTH, HEAD_DIM), 0.02),
        'na_rpb': nrm(ks[27], (DEPTH, NA_HEADS, 2 * NA_MAX_ROWS - 1, 2 * NA_COLS - 1), 0.1),
        'w_branch': nrm(ks[28], (DEPTH, N_BRANCH, BRANCH_WIDTH, D_MODEL), BRANCH_WIDTH ** -0.5),
        'w_out': nrm(ks[29], (DEPTH, D_MODEL, D_MODEL), D_MODEL ** -0.5),
    }


def reference(x, c, ctx, c_ctx, w_ada, b_ada, norm_g, ffn_w_gate, ffn_w_up, ffn_w_down,
              w_in, hy_short_w, hy_short_b, hy_pe_w0, hy_pe_b0, hy_pe_w1, hy_pe_b1,
              hy_pe_w2, hy_pe_b2, hy_pe_wout, hy_sin_freq, hy_bias,
              swa_q_gain, swa_k_gain, swa_sink, na_q_gain, na_k_gain, na_rpb,
              w_branch, w_out):
    seq = x.shape[1]
    rope = axial_rope_tables(seq)
    xc = ctx
    for i in range(DEPTH):
        update_ctx = i < DEPTH - 1
        mods = jnp.split((jax.nn.silu(c) @ w_ada[i] + b_ada[i])[:, None, :], N_MOD, axis=-1)
        mods_c = jnp.split(jax.nn.silu(c_ctx) @ w_ada[i] + b_ada[i], N_MOD, axis=-1)

        x = ffn_half_step(x, mods[0:3], norm_g[i, 0], ffn_w_gate[i, 0], ffn_w_up[i, 0], ffn_w_down[i, 0])
        xc = ffn_half_step(xc, mods_c[0:3], norm_g[i, 0], ffn_w_gate[i, 0], ffn_w_up[i, 0], ffn_w_down[i, 0])

        h = modulate(rms_norm(x, norm_g[i, 1]), mods[3], mods[4])
        hc = modulate(rms_norm(xc, norm_g[i, 1]), mods_c[3], mods_c[4])
        z_hy, z_swa, z_na, z_gate = jnp.split(h @ w_in[i], IN_SPLITS, axis=-1)
        zc_hy, zc_swa, zc_na, zc_gate = jnp.split(hc @ w_in[i], IN_SPLITS, axis=-1)
        filt = (hy_pe_w0[i], hy_pe_b0[i], hy_pe_w1[i], hy_pe_b1[i], hy_pe_w2[i], hy_pe_b2[i],
                hy_pe_wout[i], hy_sin_freq[i])

        qc_s, kc_s, vc_s = split_qkv(zc_swa, SWA_HEADS, SWA_KV_HEADS)
        kc_s = rms_norm(kc_s, swa_k_gain[i])
        qc_n, kc_n, vc_n = split_qkv(zc_na, NA_HEADS, NA_HEADS)
        kc_n = rms_norm(kc_n, na_k_gain[i])

        q_s, k_s, v_s = split_qkv(z_swa, SWA_HEADS, SWA_KV_HEADS)
        q_s = apply_axial_rope(rms_norm(q_s, swa_q_gain[i]), rope)
        k_s = apply_axial_rope(rms_norm(k_s, swa_k_gain[i]), rope)
        q_n, k_n, v_n = split_qkv(z_na, NA_HEADS, NA_HEADS)
        q_n = rms_norm(q_n, na_q_gain[i])
        k_n = rms_norm(k_n, na_k_gain[i])
        y_hy = hyena_branch(z_hy, hy_short_w[i], hy_short_b[i], filt, hy_bias[i])
        y_swa = window_gqa(q_s, k_s, v_s, kc_s, vc_s, swa_sink[i])
        y_na = neighbourhood_attention(q_n, k_n, v_n, kc_n, vc_n, na_rpb[i])
        x = x + mods[5] * merge_branches((y_hy, y_swa, y_na), z_gate, w_branch[i], w_out[i])

        if update_ctx:
            yc_hy = hyena_branch(zc_hy, hy_short_w[i], hy_short_b[i], filt, hy_bias[i])
            yc_swa = context_attention(rms_norm(qc_s, swa_q_gain[i]), kc_s, vc_s, swa_sink[i])
            yc_na = context_attention(rms_norm(qc_n, na_q_gain[i]), kc_n, vc_n, None)
            xc = xc + mods_c[5] * merge_branches((yc_hy, yc_swa, yc_na), zc_gate, w_branch[i], w_out[i])

        x = ffn_half_step(x, mods[6:9], norm_g[i, 2], ffn_w_gate[i, 1], ffn_w_up[i, 1], ffn_w_down[i, 1])
        if update_ctx:
            xc = ffn_half_step(xc, mods_c[6:9], norm_g[i, 2], ffn_w_gate[i, 1], ffn_w_up[i, 1], ffn_w_down[i, 1])
    return x
```

```cpp
#include <hip/hip_runtime.h>
#include <hip/hip_cooperative_groups.h>
#include <cstdio>
namespace cg = cooperative_groups;

typedef unsigned short u16;
typedef __attribute__((ext_vector_type(8))) short s16x8;
typedef __attribute__((ext_vector_type(16))) float f32x16;
#define DI __device__ __forceinline__
#define MFMA(a, b, c) __builtin_amdgcn_mfma_f32_32x32x16_bf16((a), (b), (c), 0, 0, 0)

constexpr int TL = 16384, TC = 2048, TT = 18432;
constexpr int NTHR = 256;
#ifndef PROBE
#define PROBE 0
#endif
#ifndef ATT_NEW
#define ATT_NEW 7
#endif
#define REP(k) for (int rep_ = 0; rep_ < (PROBE == (k) ? 2 : 1); ++rep_)

constexpr size_t OFF_BAR  = 0;
constexpr size_t OFF_MODS = 16384;
constexpr size_t SZ_MODS  = (size_t)4 * 9 * 9216 * 4;
constexpr size_t OFF_MODP = OFF_MODS + SZ_MODS;
constexpr size_t OFF_ROPE = OFF_MODP + 8 * SZ_MODS;
constexpr size_t OFF_RPB  = OFF_ROPE + 16384;
constexpr size_t OFF_FL   = OFF_RPB + 307200;
constexpr size_t OFF_FC   = OFF_FL + (size_t)4 * 4 * 512 * 2048 * 2;
constexpr size_t OFF_XS   = OFF_FC + (size_t)4 * 4 * 512 * 256 * 2;
constexpr size_t OFF_H    = OFF_XS + (size_t)TT * 1024 * 4;
constexpr size_t OFF_Z    = OFF_H + (size_t)TT * 1024 * 2;
constexpr size_t OFF_ZH   = OFF_Z;
constexpr size_t OFF_ZHC  = OFF_ZH + (size_t)8 * 1536 * 2048 * 2;
constexpr size_t OFF_QS   = OFF_ZHC + (size_t)8 * 1536 * 256 * 2;
constexpr size_t OFF_KS   = OFF_QS + (size_t)8 * 8 * 2304 * 64 * 2;
constexpr size_t OFF_VTS  = OFF_KS + (size_t)8 * 2 * 2304 * 64 * 2;
constexpr size_t OFF_QN   = OFF_VTS + (size_t)8 * 2 * 2304 * 64 * 2;
constexpr size_t OFF_KN   = OFF_QN + (size_t)8 * 8 * 2304 * 64 * 2;
constexpr size_t OFF_VTN  = OFF_KN + (size_t)8 * 8 * 2304 * 64 * 2;
constexpr size_t OFF_GATE = OFF_VTN + (size_t)8 * 8 * 2304 * 64 * 2;
constexpr size_t OFF_HID  = OFF_Z;
constexpr size_t OFF_Y    = OFF_GATE + (size_t)TT * 3072 * 2;
constexpr size_t OFF_W    = OFF_Y + (size_t)3 * TT * 512 * 2;
constexpr size_t W_GU0 = 0, W_D0 = 5767168, W_GU1 = 8650752, W_D1 = 14417920, W_IN = 17301504, W_B = 24379392, W_O = 25952256, W_END = 27000832;
constexpr size_t WS_NEED  = OFF_W + W_END * 2;

struct Params {
  const float *x, *c, *ctx, *c_ctx, *w_ada, *b_ada, *norm_g, *ffn_wg, *ffn_wu, *ffn_wd, *w_in,
      *hy_short_w, *hy_short_b, *pe_w0, *pe_b0, *pe_w1, *pe_b1, *pe_w2, *pe_b2, *pe_wout, *sin_freq, *hy_bias,
      *swa_qg, *swa_kg, *swa_sink, *na_qg, *na_kg, *na_rpb, *w_branch, *w_out;
  float* out;
  char* ws;
};

DI int opaque_tid() { int t = threadIdx.x; asm volatile("" : "+v"(t)); return t; }
#define TIDX opaque_tid()
#define GAS __attribute__((address_space(1)))
template <class T>
DI GAS T* uptr(T* p) {
  const unsigned long long v = (unsigned long long)p;
  const unsigned lo = __builtin_amdgcn_readfirstlane((unsigned)v), hi = __builtin_amdgcn_readfirstlane((unsigned)(v >> 32));
  return (GAS T*)(((unsigned long long)hi << 32) | lo);
}
DI int opaque0() { int z = 0; asm volatile("" : "+v"(z)); return z; }
typedef __bf16 bf16x2_t __attribute__((ext_vector_type(2)));
DI u16 f2bf(float x) { return __builtin_bit_cast(u16, (__bf16)x); }
DI float bf2f(u16 v) { return __uint_as_float(((unsigned)v) << 16); }
DI unsigned pack2(float a, float b) { bf16x2_t v = {(__bf16)a, (__bf16)b}; return __builtin_bit_cast(unsigned, v); }
DI int crow(int reg, int h) { return (reg & 3) + 8 * (reg >> 2) + 4 * h; }
DI float sigmoidf_(float x) { return __builtin_amdgcn_rcpf(1.f + __expf(-x)); }

#define XB_TMO      128
#define XB_XCNT(j)  (256  + 64 * (j))
#define XB_XSUB(j)  (1280 + 64 * (j))
#define XB_XGEN(j)  (2304 + 64 * (j))
#define XB_TOP      3328
#define XB_TOPGEN   3392
#define XCD_BAR_WORDS 3456
#define XB_SPIN_CAP (1u << 22)
#define LAS __attribute__((address_space(3)))
DI unsigned xb_ld(unsigned* p) { return __hip_atomic_load(p, __ATOMIC_RELAXED, __HIP_MEMORY_SCOPE_AGENT); }
DI unsigned xb_add(unsigned* p, unsigned v) { return __hip_atomic_fetch_add(p, v, __ATOMIC_RELAXED, __HIP_MEMORY_SCOPE_AGENT); }
DI unsigned xb_xcc_id() { return (unsigned)__builtin_amdgcn_s_getreg((3 << 11) | 20) & 0xFu; }
#define XB_SPIN(cond, bar) do { unsigned _sp = 0; while (cond) { __builtin_amdgcn_s_sleep(1); \
    if ((++_sp & 255u) == 0u) { if (xb_ld(&(bar)[XB_TMO])) break; if (_sp > XB_SPIN_CAP) { atomicAdd(&(bar)[XB_TMO], 1u); break; } } } } while (0)
struct XcdBarrier { unsigned* bar; unsigned x; volatile LAS unsigned* st; };
DI XcdBarrier xcd_barrier_post(unsigned* bar, volatile LAS unsigned* st) {
  XcdBarrier b; b.bar = bar; b.x = xb_xcc_id(); b.st = st;
  if (threadIdx.x == 0) (void)xb_add(&bar[XB_XCNT(b.x)], 1u);
  return b;
}
DI void xcd_barrier_complete(unsigned* bar, unsigned x, unsigned& nloc, unsigned& nx) {
  const unsigned G = gridDim.x;
  unsigned sum, cnt, mine, sp = 0u;
  for (;;) {
    sum = 0u; cnt = 0u; mine = 0u;
#pragma unroll
    for (unsigned j = 0; j < 16; ++j) { const unsigned c = xb_ld(&bar[XB_XCNT(j)]); sum += c; cnt += (c > 0u) ? 1u : 0u; mine = (j == x) ? c : mine; }
    if (sum == G) break;
    __builtin_amdgcn_s_sleep(1);
    if ((++sp & 255u) == 0u) { if (xb_ld(&bar[XB_TMO])) break; if (sp > XB_SPIN_CAP) { atomicAdd(&bar[XB_TMO], 1u); break; } }
  }
  nloc = mine > 0u ? mine : 1u; nx = cnt > 0u ? cnt : 1u;
}
DI void xcd_barrier(const XcdBarrier& b) {
  asm volatile("s_waitcnt vmcnt(0)" ::: "memory");
  __syncthreads();
  if (threadIdx.x == 0) {
    unsigned* bar = b.bar;
    __builtin_amdgcn_s_waitcnt(0);
    unsigned nloc = b.st[0], nx = b.st[1];
    if (nloc == 0u) { xcd_barrier_complete(bar, b.x, nloc, nx); b.st[0] = nloc; b.st[1] = nx; }
    const unsigned old = xb_add(&bar[XB_XSUB(b.x)], 1u);
    const unsigned gen = old / nloc;
    if (old + 1u == (gen + 1u) * nloc) {
      __builtin_amdgcn_fence(__ATOMIC_RELEASE, "agent");
      asm volatile("s_waitcnt vmcnt(0)" ::: "memory");
      const unsigned og = xb_add(&bar[XB_TOP], 1u);
      const unsigned tg = og / nx;
      if (og + 1u == (tg + 1u) * nx) xb_add(&bar[XB_TOPGEN], 1u);
      else XB_SPIN(xb_ld(&bar[XB_TOPGEN]) == tg, bar);
      __builtin_amdgcn_fence(__ATOMIC_ACQUIRE, "agent");
      xb_add(&bar[XB_XGEN(b.x)], 1u);
      asm volatile("s_waitcnt vmcnt(0)" ::: "memory");
    } else {
      XB_SPIN(xb_ld(&bar[XB_XGEN(b.x)]) == gen, bar);
      __builtin_amdgcn_fence(__ATOMIC_ACQUIRE, "agent");
      asm volatile("s_waitcnt vmcnt(0)" ::: "memory");
    }
  }
  __syncthreads();
}

DI void mods_partial(const Params& p, char* wsb, int it, char* lds) {
  const int tid = TIDX;
  const int layer = it / 72, rem = it % 72, cgp = rem >> 3, kc = rem & 7;
  float* s = (float*)lds;
  for (int i = tid; i < 9 * 128; i += NTHR) {
    int r = i >> 7, k = kc * 128 + (i & 127);
    float v = r < 8 ? p.c[r * 1024 + k] : p.c_ctx[k];
    s[i] = v / (1.f + __expf(-v));
  }
  __syncthreads();
  const float* w = p.w_ada + (size_t)layer * 1024 * 9216 + (size_t)(kc * 128) * 9216 + cgp * 1024 + tid * 4;
  float acc[9][4];
#pragma unroll
  for (int r = 0; r < 9; ++r) { acc[r][0] = acc[r][1] = acc[r][2] = acc[r][3] = 0.f; }
#pragma unroll 4
  for (int k = 0; k < 128; ++k) {
    float4 wv = *(const float4*)(w + (size_t)k * 9216);
#pragma unroll
    for (int r = 0; r < 9; ++r) {
      float sv = s[r * 128 + k];
      acc[r][0] += sv * wv.x; acc[r][1] += sv * wv.y; acc[r][2] += sv * wv.z; acc[r][3] += sv * wv.w;
    }
  }
  float* mp = (float*)(wsb + OFF_MODP);
#pragma unroll
  for (int r = 0; r < 9; ++r) {
    float4 o = make_float4(acc[r][0], acc[r][1], acc[r][2], acc[r][3]);
    *(float4*)(mp + ((size_t)((kc * 4 + layer) * 9 + r)) * 9216 + cgp * 1024 + tid * 4) = o;
  }
  __syncthreads();
}

DI void mlp_layer(const float* in, int in_ld, int nin, float* outp, const float* w, const float* bias, const float* freq) {
  const int tid = TIDX, lag = tid >> 3, fg = tid & 7;
  float a8[8];
#pragma unroll
  for (int q = 0; q < 8; ++q) a8[q] = bias[fg * 8 + q];
#pragma unroll 2
  for (int e = 0; e < nin; ++e) {
    float zv = in[lag * in_ld + e];
#pragma unroll
    for (int q = 0; q < 8; ++q) a8[q] += zv * w[e * 64 + fg * 8 + q];
  }
#pragma unroll
  for (int q = 0; q < 8; ++q) outp[lag * 64 + fg * 8 + q] = sinf(freq[fg * 8 + q] * a8[q]);
}

DI void filter_item(const Params& p, char* wsb, int it, char* lds) {
  const int tid = TIDX;
  const int layer = it / 72, ch = it % 72;
  const bool lat = ch < 64;
  const int L = lat ? 2048 : 256;
  const int l0 = lat ? ch * 32 : (ch - 64) * 32;
  float* zs = (float*)lds;
  float* a0 = zs + 32 * 34;
  float* a1 = a0 + 2048;
  {
    int lag = tid >> 3, j = tid & 7, l = l0 + lag;
    float wl = (6.283185307179586f / (float)L) * (float)l;
#pragma unroll
    for (int q = 0; q < 2; ++q) {
      int e = 2 * j + q;
      float f = 1e-4f + (float)e * ((15.f - 1e-4f) / 15.f);
      zs[lag * 34 + 1 + e] = cosf(f * wl);
      zs[lag * 34 + 17 + e] = -sinf(f * wl);
    }
    if (j == 0) zs[lag * 34] = (float)l / (float)(L - 1);
  }
  __syncthreads();
  const float* freq = p.sin_freq + layer * 64;
  mlp_layer(zs, 34, 33, a0, p.pe_w0 + layer * 33 * 64, p.pe_b0 + layer * 64, freq);
  __syncthreads();
  mlp_layer(a0, 64, 64, a1, p.pe_w1 + layer * 64 * 64, p.pe_b1 + layer * 64, freq);
  __syncthreads();
  mlp_layer(a1, 64, 64, a0, p.pe_w2 + layer * 64 * 64, p.pe_b2 + layer * 64, freq);
  __syncthreads();
  const int col0 = tid * 8, os = col0 >> 9, c0 = col0 & 511;
  const float* wout = p.pe_wout + (size_t)layer * 64 * 2048 + col0;
  u16* dstb = lat ? (u16*)(wsb + OFF_FL) + ((size_t)(layer * 4 + os) * 512 + c0) * 2048
                  : (u16*)(wsb + OFF_FC) + ((size_t)(layer * 4 + os) * 512 + c0) * 256;
  const float mind = -3.0701134573253946f, maxd = -15.350567286626973f;
#pragma unroll 1
  for (int g = 0; g < 8; ++g) {
    float acc[4][8];
#pragma unroll
    for (int a = 0; a < 4; ++a)
#pragma unroll
      for (int b = 0; b < 8; ++b) acc[a][b] = 0.f;
#pragma unroll 2
    for (int f = 0; f < 64; ++f) {
      float4 w0 = *(const float4*)(wout + (size_t)f * 2048), w1 = *(const float4*)(wout + (size_t)f * 2048 + 4);
      float wv[8] = {w0.x, w0.y, w0.z, w0.w, w1.x, w1.y, w1.z, w1.w};
#pragma unroll
      for (int lg = 0; lg < 4; ++lg) {
        float av = a0[(4 * g + lg) * 64 + f];
#pragma unroll
        for (int cc = 0; cc < 8; ++cc) acc[lg][cc] += av * wv[cc];
      }
    }
#pragma unroll
    for (int cc = 0; cc < 8; ++cc) {
      float delta = fabsf(mind + (maxd - mind) * ((float)(c0 + cc) / 511.f));
      float v[4];
#pragma unroll
      for (int lg = 0; lg < 4; ++lg) {
        float t = (float)(l0 + 4 * g + lg) / (float)(L - 1);
        v[lg] = acc[lg][cc] * __expf(-t * delta);
      }
      *(uint2*)(dstb + (size_t)cc * L + l0 + 4 * g) = make_uint2(pack2(v[0], v[1]), pack2(v[2], v[3]));
    }
  }
  __syncthreads();
}

DI void rope_item(const Params& p, char* wsb) {
  float* rt = (float*)(wsb + OFF_ROPE);
  for (int i = TIDX; i < 96 * 16; i += NTHR) {
    int pos = i >> 4, j = i & 15;
    float inv = 1.f / powf(10000.f, (float)(2 * j) / 32.f);
    if (pos < 32) { float a = (float)pos * inv; rt[pos * 16 + j] = cosf(a); rt[512 + pos * 16 + j] = sinf(a); }
    else { int cpos = pos - 32; float a = (float)cpos * inv; rt[1024 + cpos * 16 + j] = cosf(a); rt[2048 + cpos * 16 + j] = sinf(a); }
  }
  float* rb = (float*)(wsb + OFF_RPB);
  for (int i = TIDX; i < 4 * 8 * 15 * 160; i += NTHR) {
    int row = i / 160, e = i % 160;
    rb[i] = (e >= 64 && e < 95) ? p.na_rpb[row * 31 + e - 64] : 0.f;
  }
}

DI void phase_prep(const Params& p, char* wsb, char* lds) {
  const int nb = gridDim.x, bid = blockIdx.x, tid = TIDX;
  float4* xs = (float4*)(wsb + OFF_XS);
  const float4* xin = (const float4*)p.x;
  const float4* cin = (const float4*)p.ctx;
  const size_t nl = (size_t)TL * 256, nc = (size_t)TC * 256;
  {
    const size_t stride = (size_t)nb * NTHR;
#pragma unroll 8
    for (size_t i = (size_t)bid * NTHR + tid; i < nl; i += stride) xs[i] = xin[i];
#pragma unroll 8
    for (size_t i = (size_t)bid * NTHR + tid; i < nc; i += stride) xs[nl + i] = cin[i];
  }
  for (int it = bid; it < 577; it += nb) {
    if (it < 288) mods_partial(p, wsb, it, lds);
    else if (it < 576) filter_item(p, wsb, it - 288, lds);
    else rope_item(p, wsb);
  }
}

DI void phase_mods_reduce(const Params& p, char* wsb) {
  float* mods = (float*)(wsb + OFF_MODS);
  const float* mp = (const float*)(wsb + OFF_MODP);
  const int n = 4 * 9 * 9216;
  for (int i = blockIdx.x * NTHR + TIDX; i < n; i += gridDim.x * NTHR) {
    int layer = i / (9 * 9216), col = i % 9216;
    float s = p.b_ada[layer * 9216 + col];
#pragma unroll
    for (int k = 0; k < 8; ++k) s += mp[(size_t)k * n + i];
    mods[i] = s;
  }
}

DI void convert_tile(const float* __restrict__ src, int N, u16* __restrict__ dst, int K, int k0, int n0, int mode, float* t) {
  const int tid = TIDX;
#pragma unroll
  for (int i = 0; i < 4; ++i) {
    int q = tid + NTHR * i, kr = q >> 4, nc = (q & 15) * 4;
    float4 v = *(const float4*)(src + (size_t)(k0 + kr) * N + n0 + nc);
    t[kr * 65 + nc] = v.x; t[kr * 65 + nc + 1] = v.y; t[kr * 65 + nc + 2] = v.z; t[kr * 65 + nc + 3] = v.w;
  }
  __syncthreads();
#pragma unroll
  for (int i = 0; i < 2; ++i) {
    int q = tid + NTHR * i, nr = q >> 3, kc = (q & 7) * 8;
    float v[8];
#pragma unroll
    for (int e = 0; e < 8; ++e) v[e] = t[(kc + e) * 65 + nr];
    int n = n0 + nr;
    int dn = mode == 0 ? n : (64 * (n >> 5) + (n & 31) + (mode == 2 ? 32 : 0));
    *(uint4*)(dst + (size_t)dn * K + k0 + kc) = make_uint4(pack2(v[0], v[1]), pack2(v[2], v[3]), pack2(v[4], v[5]), pack2(v[6], v[7]));
  }
  __syncthreads();
}

DI void convert_item(const Params& p, char* wsb, int layer, int it, char* lds) {
  u16* W = (u16*)(wsb + OFF_W);
  const float* src; u16* dst; int K, N, mode = 0, t = it;
  if (t < 4224) {
    int f = t / 2112; t %= 2112;
    int which = t / 704; t %= 704;
    size_t base = (size_t)(layer * 2 + f) * 1024 * 2816;
    if (which == 0) { src = p.ffn_wg + base; dst = W + (f ? W_GU1 : W_GU0); K = 1024; N = 2816; mode = 1; }
    else if (which == 1) { src = p.ffn_wu + base; dst = W + (f ? W_GU1 : W_GU0); K = 1024; N = 2816; mode = 2; }
    else { src = p.ffn_wd + base; dst = W + (f ? W_D1 : W_D0); K = 2816; N = 1024; }
  } else if (t < 4224 + 1728) {
    t -= 4224; src = p.w_in + (size_t)layer * 1024 * 6912; dst = W + W_IN; K = 1024; N = 6912;
  } else if (t < 4224 + 1728 + 384) {
    t -= 5952; int j = t / 128; t %= 128;
    src = p.w_branch + (size_t)(layer * 3 + j) * 512 * 1024; dst = W + W_B + (size_t)j * 1024 * 512; K = 512; N = 1024;
  } else {
    t -= 6336; src = p.w_out + (size_t)layer * 1024 * 1024; dst = W + W_O; K = 1024; N = 1024;
  }
  int ktiles = K >> 6;
  int kt = t % ktiles, nt = t / ktiles;
  convert_tile(src, N, dst, K, kt * 64, nt * 64, mode, (float*)lds);
}

DI void phase_norm(const Params& p, char* wsb, int layer, int which, int mrows, bool do_convert, char* lds) {
  const int tid = TIDX, lane = tid & 63, wid = tid >> 6;
  const float* xs = (const float*)(wsb + OFF_XS);
  u16* H = (u16*)(wsb + OFF_H);
  const float* mods = (const float*)(wsb + OFF_MODS) + (size_t)layer * 9 * 9216;
  const float* g = p.norm_g + (layer * 3 + which) * 1024;
  const int nw = gridDim.x * 4;
#pragma unroll 2
  for (int row = blockIdx.x * 4 + wid; row < mrows; row += nw) {
    const float4* xr = (const float4*)(xs + (size_t)row * 1024);
    float4 v[4];
    float ss = 0.f;
#pragma unroll
    for (int i = 0; i < 4; ++i) { v[i] = xr[lane + 64 * i]; ss += v[i].x * v[i].x + v[i].y * v[i].y + v[i].z * v[i].z + v[i].w * v[i].w; }
#pragma unroll
    for (int o = 32; o; o >>= 1) ss += __shfl_xor(ss, o);
    const float r = rsqrtf(ss * (1.f / 1024.f) + 1e-6f);
    const int mr = row < TL ? (row >> 11) : 8;
    const float* sh = mods + (size_t)mr * 9216 + (3 * which) * 1024;
    const float* sc = sh + 1024;
#pragma unroll
    for (int i = 0; i < 4; ++i) {
      int col = (lane + 64 * i) * 4;
      float4 gg = *(const float4*)(g + col), s4 = *(const float4*)(sh + col), c4 = *(const float4*)(sc + col);
      float o0 = v[i].x * r * gg.x * (1.f + c4.x) + s4.x;
      float o1 = v[i].y * r * gg.y * (1.f + c4.y) + s4.y;
      float o2 = v[i].z * r * gg.z * (1.f + c4.z) + s4.z;
      float o3 = v[i].w * r * gg.w * (1.f + c4.w) + s4.w;
      *(uint2*)(H + (size_t)row * 1024 + col) = make_uint2(pack2(o0, o1), pack2(o2, o3));
    }
  }
  if (do_convert) {
    for (int it = blockIdx.x; it < 6592; it += gridDim.x) convert_item(p, wsb, layer, it, lds);
  }
}

template <int AI, int BI>
DI void gemm_stage(const u16* __restrict__ A, int lda, const u16* __restrict__ B, int ldb, char* buf, int tid) {
#pragma unroll
  for (int i = 0; i < 2 * AI; ++i) {
    const int S = tid + NTHR * i, row = S >> 3, c = (S & 7) ^ ((row >> 1) & 7);
    __builtin_amdgcn_global_load_lds((const unsigned*)(A + (size_t)row * lda + c * 8), (__attribute__((address_space(3))) unsigned*)(buf + S * 16), 16, 0, 0);
  }
#pragma unroll
  for (int i = 0; i < 2 * BI; ++i) {
    const int S = tid + NTHR * i, row = S >> 3, c = (S & 7) ^ ((row >> 1) & 7);
    __builtin_amdgcn_global_load_lds((const unsigned*)(B + (size_t)row * ldb + c * 8), (__attribute__((address_space(3))) unsigned*)(buf + 16384 + S * 16), 16, 0, 0);
  }
}

template <int AI, int BI>
DI void gemm_tile(const u16* __restrict__ A, int lda, const u16* __restrict__ B, int ldb, int nk, bool swap,
                  f32x16 (&acc)[AI][BI], char* lds) {
  const int tid = TIDX, lane = tid & 63, wid = tid >> 6;
  gemm_stage<AI, BI>(A, lda, B, ldb, lds, tid);
  asm volatile("s_waitcnt vmcnt(0)" ::: "memory");
  __syncthreads();
  const int wa = wid >> 1, wb = wid & 1, r = lane & 31, h = lane >> 5, sw = (r >> 1) & 7;
  const int offA = (swap ? 16384 : 0) + (wa * 32 * AI + r) * 128;
  const int offB = (swap ? 0 : 16384) + (wb * 32 * BI + r) * 128;
  for (int kt = 0; kt < nk; ++kt) {
    const char* cur = lds + (kt & 1) * 32768;
    if (kt + 1 < nk) gemm_stage<AI, BI>(A + (kt + 1) * 64, lda, B + (kt + 1) * 64, ldb, lds + ((kt + 1) & 1) * 32768, tid);
#pragma unroll
    for (int ks = 0; ks < 4; ++ks) {
      const int co = ((ks * 2 + h) ^ sw) << 4;
      s16x8 fa[AI], fb[BI];
#pragma unroll
      for (int i = 0; i < AI; ++i) fa[i] = *(const s16x8*)(cur + offA + i * 4096 + co);
#pragma unroll
      for (int i = 0; i < BI; ++i) fb[i] = *(const s16x8*)(cur + offB + i * 4096 + co);
#pragma unroll
      for (int i = 0; i < AI; ++i)
#pragma unroll
        for (int j = 0; j < BI; ++j) acc[i][j] = MFMA(fa[i], fb[j], acc[i][j]);
    }
    asm volatile("s_waitcnt vmcnt(0)" ::: "memory");
    __syncthreads();
  }
}

template <int AI, int BI>
DI void zero_acc(f32x16 (&acc)[AI][BI]) {
#pragma unroll
  for (int a = 0; a < AI; ++a)
#pragma unroll
    for (int b = 0; b < BI; ++b)
#pragma unroll
      for (int i = 0; i < 16; ++i) acc[a][b][i] = 0.f;
}

DI void gemm_stage_w(const u16* __restrict__ A, int lda, const u16* __restrict__ B, int ldb, char* buf, int tid) {
#pragma unroll
  for (int i = 0; i < 2; ++i) {
    const int S = tid + NTHR * i, row = S >> 2, c = (S & 3) ^ ((row >> 2) & 3);
    __builtin_amdgcn_global_load_lds((const unsigned*)(A + (size_t)row * lda + c * 8), (__attribute__((address_space(3))) unsigned*)(buf + S * 16), 16, 0, 0);
  }
#pragma unroll
  for (int i = 0; i < 4; ++i) {
    const int S = tid + NTHR * i, row = S >> 2, c = (S & 3) ^ ((row >> 2) & 3);
    __builtin_amdgcn_global_load_lds((const unsigned*)(B + (size_t)row * ldb + c * 8), (__attribute__((address_space(3))) unsigned*)(buf + 8192 + S * 16), 16, 0, 0);
  }
}
DI void gemm_tile_w(const u16* __restrict__ A, int lda, const u16* __restrict__ B, int ldb, int nk, bool swap,
                    f32x16 (&acc)[2][4], char* lds) {
  const int tid = TIDX, lane = tid & 63, wid = tid >> 6;
  gemm_stage_w(A, lda, B, ldb, lds, tid);
  asm volatile("s_waitcnt vmcnt(0)" ::: "memory");
  __syncthreads();
  const int r = lane & 31, h = lane >> 5, sw = (r >> 2) & 3;
  const int wa = swap ? wid : (wid >> 1), wb = swap ? 0 : (wid & 1);
  const int offF = (swap ? 8192 : 0) + (wa * 64 + r) * 64;
  const int offS = (swap ? 0 : 8192) + (wb * 128 + r) * 64;
  for (int kt = 0; kt < nk; ++kt) {
    const char* cur = lds + (kt & 1) * 24576;
    if (kt + 1 < nk) gemm_stage_w(A + (kt + 1) * 32, lda, B + (kt + 1) * 32, ldb, lds + ((kt + 1) & 1) * 24576, tid);
#pragma unroll
    for (int ks = 0; ks < 2; ++ks) {
      const int co = ((ks * 2 + h) ^ sw) << 4;
      s16x8 f0 = *(const s16x8*)(cur + offF + co), f1 = *(const s16x8*)(cur + offF + 2048 + co);
#pragma unroll
      for (int si = 0; si < 4; ++si) {
        s16x8 sb = *(const s16x8*)(cur + offS + si * 2048 + co);
        acc[0][si] = MFMA(f0, sb, acc[0][si]);
        acc[1][si] = MFMA(f1, sb, acc[1][si]);
      }
    }
    asm volatile("s_waitcnt vmcnt(0)" ::: "memory");
    __syncthreads();
  }
}
DI void zero_acc_w(f32x16 (&acc)[2][4]) {
#pragma unroll
  for (int a = 0; a < 2; ++a)
#pragma unroll
    for (int b = 0; b < 4; ++b)
#pragma unroll
      for (int i = 0; i < 16; ++i) acc[a][b][i] = 0.f;
}

DI bool next_tile(int rnd, int MT, int NT, int& mt, int& nt) {
  const int G8 = gridDim.x >> 3, x = blockIdx.x & 7, slot = blockIdx.x >> 3;
  const int T = (rnd * 8 + x) * G8 + slot;
  if (T >= MT * NT) return false;
  const int band = T / (NT * 8), rem = T - band * NT * 8;
  nt = rem >> 3; mt = band * 8 + (rem & 7);
  return true;
}

template <int AI>
DI void gu_tile(char* wsb, int sub, int m0, int n0, char* lds) {
  const u16* H = (const u16*)(wsb + OFF_H);
  const u16* W = (const u16*)(wsb + OFF_W) + (sub ? W_GU1 : W_GU0);
  u16* HID = (u16*)(wsb + OFF_HID);
  const int lane = TIDX & 63, wid = TIDX >> 6, wa = wid >> 1, wb = wid & 1, r = lane & 31, h = lane >> 5;
  f32x16 acc[AI][2]; zero_acc<AI, 2>(acc);
  gemm_tile<AI, 2>(H + (size_t)m0 * 1024, 1024, W + (size_t)n0 * 1024, 1024, 16, false, acc, lds);
  const int m0e = m0 + opaque0();
  const int hc = (n0 >> 1) + wb * 32 + r;
  GAS u16* HIDu = uptr(HID);
  const unsigned ib = (unsigned)((m0e + wa * 32 * AI + 4 * h) * 2816 + hc);
#pragma unroll
  for (int ai = 0; ai < AI; ++ai)
#pragma unroll
    for (int reg = 0; reg < 16; ++reg) {
      float g = acc[ai][0][reg], u = acc[ai][1][reg];
      float v = g * __builtin_amdgcn_rcpf(1.f + __expf(-g)) * u;
      HIDu[ib + (unsigned)((ai * 32 + (reg & 3) + 8 * (reg >> 2)) * 2816)] = f2bf(v);
      if ((reg & 7) == 7) __builtin_amdgcn_sched_barrier(0);
    }
}
DI void phase_gu(const Params& p, char* wsb, int sub, int mrows, char* lds) {
  int mt, nt;
  for (int rnd = 0; next_tile(rnd, 128, 44, mt, nt); ++rnd) gu_tile<2>(wsb, sub, mt * 128, nt * 128, lds);
  if (mrows > TL)
    for (int rnd = 0; next_tile(rnd, 32, 44, mt, nt); ++rnd) gu_tile<1>(wsb, sub, TL + mt * 64, nt * 128, lds);
}

template <int AI, int BI>
DI void dn_tile(const Params& p, char* wsb, int layer, int sub, bool final_out, int m0, int n0, char* lds) {
  const u16* HID = (const u16*)(wsb + OFF_HID);
  const u16* W = (const u16*)(wsb + OFF_W) + (sub ? W_D1 : W_D0);
  float* xs = (float*)(wsb + OFF_XS);
  const float* mods = (const float*)(wsb + OFF_MODS) + (size_t)layer * 9 * 9216;
  const int lane = TIDX & 63, wid = TIDX >> 6, wa = wid >> 1, wb = wid & 1, r = lane & 31, h = lane >> 5;
  f32x16 acc[AI][BI]; zero_acc<AI, BI>(acc);
  gemm_tile<AI, BI>(HID + (size_t)m0 * 2816, 2816, W + (size_t)n0 * 2816, 2816, 44, false, acc, lds);
  const int m0e = m0 + opaque0();
  const int mr = m0 < TL ? (m0 >> 11) : 8;
  const float* gate = mods + (size_t)mr * 9216 + (2 + 6 * sub) * 1024;
  GAS float* xsu = uptr(xs);
  GAS float* outu = uptr(p.out);
#pragma unroll
  for (int bi = 0; bi < BI; ++bi) {
    const int n = n0 + wb * 32 * BI + bi * 32 + r;
    const float gv = 0.5f * gate[n];
    const unsigned ib = (unsigned)((m0e + wa * 32 * AI + 4 * h) * 1024 + n);
#pragma unroll
    for (int ai = 0; ai < AI; ++ai)
#pragma unroll
      for (int reg = 0; reg < 16; ++reg) {
        const unsigned idx = ib + (unsigned)((ai * 32 + (reg & 3) + 8 * (reg >> 2)) * 1024);
        float v = xsu[idx] + gv * acc[ai][bi][reg];
        if (final_out) outu[idx] = v; else xsu[idx] = v;
        if ((reg & 7) == 7) __builtin_amdgcn_sched_barrier(0);
      }
  }
}
DI void phase_dn(const Params& p, char* wsb, int layer, int sub, int mrows, bool final_out, char* lds) {
  int mt, nt;
  for (int rnd = 0; next_tile(rnd, 128, 8, mt, nt); ++rnd) dn_tile<2, 2>(p, wsb, layer, sub, final_out, mt * 128, nt * 128, lds);
  if (mrows > TL)
    for (int rnd = 0; next_tile(rnd, 32, 16, mt, nt); ++rnd) dn_tile<1, 1>(p, wsb, layer, sub, final_out, TL + mt * 64, nt * 64, lds);
}

DI void phase_in(const Params& p, char* wsb, int layer, char* lds) {
  const u16* H = (const u16*)(wsb + OFF_H);
  const u16* W = (const u16*)(wsb + OFF_W) + W_IN;
  const float* rope = (const float*)(wsb + OFF_ROPE);
  const int lane = TIDX & 63, wid = TIDX >> 6, wa = wid >> 1, wb = wid & 1, r = lane & 31, h = lane >> 5;
  int mt, nt;
  for (int rnd = 0; next_tile(rnd, 144, 54, mt, nt); ++rnd) {
    const int m0 = mt * 128, n0 = nt * 128;
    const bool swap = n0 < 3840;
    f32x16 acc[2][2]; zero_acc<2, 2>(acc);
    gemm_tile<2, 2>(H + (size_t)m0 * 1024, 1024, W + (size_t)n0 * 1024, 1024, 16, swap, acc, lds);
    const int m0e = m0 + opaque0();
    if (!swap) {
      GAS u16* G = uptr((u16*)(wsb + OFF_GATE));
#pragma unroll
      for (int bi = 0; bi < 2; ++bi) {
        const int n = n0 - 3840 + wb * 64 + bi * 32 + r;
        const unsigned ib = (unsigned)((m0e + wa * 64 + 4 * h) * 3072 + n);
#pragma unroll
        for (int ai = 0; ai < 2; ++ai)
#pragma unroll
          for (int reg = 0; reg < 16; ++reg)
            G[ib + (unsigned)((ai * 32 + (reg & 3) + 8 * (reg >> 2)) * 3072)] = f2bf(sigmoidf_(acc[ai][bi][reg]));
      }
      continue;
    }
    const bool isctx = m0 >= TL;
    if (n0 < 1536) {
#pragma unroll
      for (int bi = 0; bi < 2; ++bi) {
        const int m = m0e + wb * 64 + bi * 32 + r;
        u16* dst; size_t tstride;
        if (!isctx) { int b = m >> 11, t = m & 2047; dst = (u16*)(wsb + OFF_ZH) + (size_t)b * 1536 * 2048 + t; tstride = 2048; }
        else { int mm = m - TL; int b = mm >> 8, t = mm & 255; dst = (u16*)(wsb + OFF_ZHC) + (size_t)b * 1536 * 256 + t; tstride = 256; }
#pragma unroll
        for (int ai = 0; ai < 2; ++ai)
#pragma unroll
          for (int reg = 0; reg < 16; ++reg) {
            int n = n0 + wa * 64 + ai * 32 + crow(reg, h);
            dst[(size_t)n * tstride] = f2bf(acc[ai][bi][reg]);
          }
      }
      continue;
    }
    int kind, head;
    bool na;
    {
      int nn = n0 + wa * 64;
      if (nn < 2304) { na = false; int o = nn - 1536; if (o < 512) { kind = 0; head = o >> 6; } else if (o < 640) { kind = 1; head = (o - 512) >> 6; } else { kind = 2; head = (o - 640) >> 6; } }
      else { na = true; int o = nn - 2304; kind = o >> 9; head = (o & 511) >> 6; }
    }
    const int nheads = (!na && kind != 0) ? 2 : 8;
#pragma unroll
    for (int bi = 0; bi < 2; ++bi) {
      const int m = m0e + wb * 64 + bi * 32 + r;
      int b, tok, pos;
      if (!isctx) { b = m >> 11; pos = m & 2047; tok = pos; } else { int mm = m - TL; b = mm >> 8; pos = 0; tok = 2048 + (mm & 255); }
      if (kind == 2) {
        u16* dst = (u16*)(wsb + (na ? OFF_VTN : OFF_VTS)) + ((size_t)(b * nheads + head) * 64) * 2304 + tok;
#pragma unroll
        for (int ai = 0; ai < 2; ++ai)
#pragma unroll
          for (int reg = 0; reg < 16; ++reg) {
            int d = ai * 32 + crow(reg, h);
            dst[(size_t)d * 2304] = f2bf(acc[ai][bi][reg]);
          }
      } else {
        const float* gain = (na ? (kind == 0 ? p.na_qg : p.na_kg) : (kind == 0 ? p.swa_qg : p.swa_kg)) + layer * 64;
        float ss = 0.f;
#pragma unroll
        for (int ai = 0; ai < 2; ++ai)
#pragma unroll
          for (int reg = 0; reg < 16; ++reg) ss += acc[ai][bi][reg] * acc[ai][bi][reg];
        ss += __shfl_xor(ss, 32);
        const float rn = rsqrtf(ss * (1.f / 64.f) + 1e-6f);
        float v[2][16];
#pragma unroll
        for (int ai = 0; ai < 2; ++ai)
#pragma unroll
          for (int reg = 0; reg < 16; ++reg) v[ai][reg] = acc[ai][bi][reg] * rn * gain[ai * 32 + crow(reg, h)];
        if (!na && !isctx) {
          const int prow = pos >> 6, pcol = pos & 63;
#pragma unroll
          for (int ai = 0; ai < 2; ++ai) {
            const float* ct = ai == 0 ? rope + prow * 16 : rope + 1024 + pcol * 16;
            const float* st = ai == 0 ? rope + 512 + prow * 16 : rope + 2048 + pcol * 16;
#pragma unroll
            for (int reg = 0; reg < 8; ++reg) {
              int j = crow(reg, h);
              float cs = ct[j], sn = st[j];
              float x1 = v[ai][reg], x2 = v[ai][reg + 8];
              v[ai][reg] = x1 * cs - x2 * sn;
              v[ai][reg + 8] = x2 * cs + x1 * sn;
            }
          }
        }
        const float qs = kind == 0 ? 0.125f : 1.f;
        u16* dst = (u16*)(wsb + (na ? (kind == 0 ? OFF_QN : OFF_KN) : (kind == 0 ? OFF_QS : OFF_KS))) +
                   ((size_t)(b * nheads + head) * 2304 + tok) * 64;
#pragma unroll
        for (int ai = 0; ai < 2; ++ai)
#pragma unroll
          for (int g4 = 0; g4 < 4; ++g4) {
            int d0 = ai * 32 + 8 * g4 + 4 * h;
            *(uint2*)(dst + d0) = make_uint2(pack2(v[ai][4 * g4] * qs, v[ai][4 * g4 + 1] * qs), pack2(v[ai][4 * g4 + 2] * qs, v[ai][4 * g4 + 3] * qs));
          }
      }
    }
  }
}

template <int AI, int BI>
DI void m1_tile(char* wsb, int m0, int n0, char* lds) {
  const u16* Y = (const u16*)(wsb + OFF_Y);
  const u16* W = (const u16*)(wsb + OFF_W) + W_B;
  const u16* G = (const u16*)(wsb + OFF_GATE);
  u16* GM = (u16*)(wsb + OFF_H);
  const int tid = TIDX, lane = tid & 63, wid = tid >> 6, wa = wid >> 1, wb = wid & 1, r = lane & 31, h = lane >> 5, sw = (r >> 1) & 7;
  f32x16 tot[AI][BI], acc[AI][BI];
  zero_acc<AI, BI>(tot); zero_acc<AI, BI>(acc);
  const u16* Wt = W + (size_t)n0 * 512;
  const u16* Yt = Y + (size_t)m0 * 512;
  gemm_stage<AI, BI>(Wt, 512, Yt, 512, lds, tid);
  asm volatile("s_waitcnt vmcnt(0)" ::: "memory");
  __syncthreads();
  const int offA = (wa * 32 * AI + r) * 128;
  const int offB = 16384 + (wb * 32 * BI + r) * 128;
  uint2 gq[AI][BI][4];
#pragma unroll 1
  for (int kt = 0; kt < 24; ++kt) {
    const char* cur = lds + (kt & 1) * 32768;
    const int j = kt >> 3, kk = kt & 7;
    if (kt + 1 < 24) {
      const int j1 = (kt + 1) >> 3, k1 = (kt + 1) & 7;
      gemm_stage<AI, BI>(Wt + (size_t)j1 * 1024 * 512 + k1 * 64, 512, Yt + (size_t)j1 * TT * 512 + k1 * 64, 512, lds + ((kt + 1) & 1) * 32768, tid);
    }
    if (kk == 0) {
#pragma unroll
      for (int bi = 0; bi < BI; ++bi) {
        const size_t m = (size_t)(m0 + wb * 32 * BI + bi * 32 + r);
#pragma unroll
        for (int ai = 0; ai < AI; ++ai)
#pragma unroll
          for (int g4 = 0; g4 < 4; ++g4)
            gq[ai][bi][g4] = *(const uint2*)(G + m * 3072 + j * 1024 + n0 + wa * 32 * AI + ai * 32 + 8 * g4 + 4 * h);
      }
    }
#pragma unroll
    for (int ks = 0; ks < 4; ++ks) {
      const int co = ((ks * 2 + h) ^ sw) << 4;
      s16x8 fa[AI], fb[BI];
#pragma unroll
      for (int i = 0; i < AI; ++i) fa[i] = *(const s16x8*)(cur + offA + i * 4096 + co);
#pragma unroll
      for (int i = 0; i < BI; ++i) fb[i] = *(const s16x8*)(cur + offB + i * 4096 + co);
#pragma unroll
      for (int i = 0; i < AI; ++i)
#pragma unroll
        for (int jj = 0; jj < BI; ++jj) acc[i][jj] = MFMA(fa[i], fb[jj], acc[i][jj]);
    }
    if (kk == 7) {
#pragma unroll
      for (int ai = 0; ai < AI; ++ai)
#pragma unroll
        for (int bi = 0; bi < BI; ++bi)
#pragma unroll
          for (int g4 = 0; g4 < 4; ++g4) {
            const uint2 gv = gq[ai][bi][g4];
            tot[ai][bi][4 * g4 + 0] += bf2f((u16)(gv.x & 0xffff)) * acc[ai][bi][4 * g4 + 0];
            tot[ai][bi][4 * g4 + 1] += bf2f((u16)(gv.x >> 16)) * acc[ai][bi][4 * g4 + 1];
            tot[ai][bi][4 * g4 + 2] += bf2f((u16)(gv.y & 0xffff)) * acc[ai][bi][4 * g4 + 2];
            tot[ai][bi][4 * g4 + 3] += bf2f((u16)(gv.y >> 16)) * acc[ai][bi][4 * g4 + 3];
          }
      zero_acc<AI, BI>(acc);
    }
    asm volatile("s_waitcnt vmcnt(0)" ::: "memory");
    __syncthreads();
  }
  const int m0f = m0 + opaque0();
#pragma unroll
  for (int bi = 0; bi < BI; ++bi) {
    const size_t m = (size_t)(m0f + wb * 32 * BI + bi * 32 + r);
#pragma unroll
    for (int ai = 0; ai < AI; ++ai)
#pragma unroll
      for (int g4 = 0; g4 < 4; ++g4)
        *(uint2*)(GM + m * 1024 + n0 + wa * 32 * AI + ai * 32 + 8 * g4 + 4 * h) =
            make_uint2(pack2(tot[ai][bi][4 * g4], tot[ai][bi][4 * g4 + 1]), pack2(tot[ai][bi][4 * g4 + 2], tot[ai][bi][4 * g4 + 3]));
  }
}
DI void phase_m1(const Params& p, char* wsb, int mrows, char* lds) {
  int mt, nt;
  for (int rnd = 0; next_tile(rnd, 128, 8, mt, nt); ++rnd) m1_tile<2, 2>(wsb, mt * 128, nt * 128, lds);
  if (mrows > TL)
    for (int rnd = 0; next_tile(rnd, 32, 16, mt, nt); ++rnd) m1_tile<1, 1>(wsb, TL + mt * 64, nt * 64, lds);
}

template <int AI, int BI>
DI void m2_tile(char* wsb, int layer, int m0, int n0, char* lds) {
  const u16* GM = (const u16*)(wsb + OFF_H);
  const u16* W = (const u16*)(wsb + OFF_W) + W_O;
  float* xs = (float*)(wsb + OFF_XS);
  const float* mods = (const float*)(wsb + OFF_MODS) + (size_t)layer * 9 * 9216;
  const int lane = TIDX & 63, wid = TIDX >> 6, wa = wid >> 1, wb = wid & 1, r = lane & 31, h = lane >> 5;
  f32x16 acc[AI][BI]; zero_acc<AI, BI>(acc);
  gemm_tile<AI, BI>(GM + (size_t)m0 * 1024, 1024, W + (size_t)n0 * 1024, 1024, 16, false, acc, lds);
  const int m0e = m0 + opaque0();
  const int mr = m0 < TL ? (m0 >> 11) : 8;
  const float* gate = mods + (size_t)mr * 9216 + 5 * 1024;
  GAS float* xsu = uptr(xs);
#pragma unroll
  for (int bi = 0; bi < BI; ++bi) {
    const int n = n0 + wb * 32 * BI + bi * 32 + r;
    const float gv = gate[n];
    const unsigned ib = (unsigned)((m0e + wa * 32 * AI + 4 * h) * 1024 + n);
#pragma unroll
    for (int ai = 0; ai < AI; ++ai)
#pragma unroll
      for (int reg = 0; reg < 16; ++reg) {
        const unsigned idx = ib + (unsigned)((ai * 32 + (reg & 3) + 8 * (reg >> 2)) * 1024);
        xsu[idx] += gv * acc[ai][bi][reg];
        if ((reg & 7) == 7) __builtin_amdgcn_sched_barrier(0);
      }
  }
}
DI void phase_m2(const Params& p, char* wsb, int layer, int mrows, char* lds) {
  int mt, nt;
  for (int rnd = 0; next_tile(rnd, 128, 8, mt, nt); ++rnd) m2_tile<2, 2>(wsb, layer, mt * 128, nt * 128, lds);
  if (mrows > TL)
    for (int rnd = 0; next_tile(rnd, 32, 16, mt, nt); ++rnd) m2_tile<1, 1>(wsb, layer, TL + mt * 64, nt * 64, lds);
}

DI float sconv(const u16* z, int t, int L, float w0, float w1, float w2, float bb) {
  float zm = t > 0 ? bf2f(z[t - 1]) : 0.f, z0 = bf2f(z[t]), zp = t + 1 < L ? bf2f(z[t + 1]) : 0.f;
  return w0 * zm + w1 * z0 + w2 * zp + bb;
}

template <int NB1>
DI void hyena_item(const Params& p, char* wsb, int layer, int c, char* lds) {
  constexpr int L = NB1 * 32;
  constexpr int TPW = NB1 == 64 ? 4 : 1;
  const int tid = TIDX, lane = tid & 63, wid = tid >> 6, r = lane & 31, h = lane >> 5;
  u16* U = (u16*)lds;
  u16* R = (u16*)(lds + 40960);
  const u16* zbase = NB1 == 64 ? (const u16*)(wsb + OFF_ZH) : (const u16*)(wsb + OFF_ZHC);
  const float* sw = p.hy_short_w + layer * 3 * 1536;
  const float* sb = p.hy_short_b + layer * 1536;
  {
    const float w0 = sw[c], w1 = sw[1536 + c], w2 = sw[3072 + c], bb = sb[c];
#pragma unroll 2
    for (int ch = tid; ch < L; ch += NTHR) {
      const int b = ch / (L / 8), t = (ch % (L / 8)) * 8;
      const u16* zr = zbase + ((size_t)(b * 1536 + c)) * L;
      const uint4 zz = *(const uint4*)(zr + t);
      const float zm1 = bf2f(zr[t > 0 ? t - 1 : 0]) * (t > 0 ? 1.f : 0.f);
      const float zp8 = bf2f(zr[t + 8 < L ? t + 8 : L - 1]) * (t + 8 < L ? 1.f : 0.f);
      const unsigned zw[4] = {zz.x, zz.y, zz.z, zz.w};
      float zv[10];
      zv[0] = zm1; zv[9] = zp8;
#pragma unroll
      for (int q = 0; q < 4; ++q) { zv[1 + 2 * q] = bf2f((u16)(zw[q] & 0xffff)); zv[2 + 2 * q] = bf2f((u16)(zw[q] >> 16)); }
      float o[8];
#pragma unroll
      for (int e = 0; e < 8; ++e) o[e] = w0 * zv[e] + w1 * zv[e + 1] + w2 * zv[e + 2] + bb;
      *(uint4*)(U + (b * NB1 + (t >> 5)) * 40 + (t & 31)) = make_uint4(pack2(o[0], o[1]), pack2(o[2], o[3]), pack2(o[4], o[5]), pack2(o[6], o[7]));
    }
  }
  if (NB1 == 64) {
    unsigned acc_t = 0;
#pragma unroll
    for (int q = 0; q < 4; ++q) {
      const int b = 2 * wid + (q & 1), xc = (q >> 1 ? 1024 : 512) + c;
      const unsigned* rowp = (const unsigned*)(zbase + ((size_t)(b * 1536 + xc)) * L);
      acc_t += rowp[(lane & 31) * 32 + (lane >> 5) * 16];
    }
    asm volatile("" ::"v"(acc_t));
  }
  const bool active = NB1 == 64 ? true : (wid < 2);
  const u16* filt = NB1 == 64 ? (const u16*)(wsb + OFF_FL) : (const u16*)(wsb + OFF_FC);
  int tb[TPW], tt1[TPW];
#pragma unroll
  for (int j = 0; j < TPW; ++j) { int col = (wid * TPW + j) * 32 + r; tb[j] = col / NB1; tt1[j] = col % NB1; }
  int ub[TPW];
#pragma unroll
  for (int j = 0; j < TPW; ++j) ub[j] = ((tb[j] * NB1 + tt1[j]) * 40 + 8 * h) * 2;
  const int zaddr = 40960 + 2 * L * 2 + 64;
  const int pbase = (L - 1) - r + 8 * h;
  const unsigned sh = (unsigned)(pbase & 1) << 4;
  const unsigned* Rd = (const unsigned*)R + (pbase >> 1);
#pragma unroll 1
  for (int order = 0; order < 2; ++order) {
    __syncthreads();
    {
      const u16* fp = filt + ((size_t)((layer * 4 + order * 2 + 0) * 512 + c)) * L;
      const u16* fn = filt + ((size_t)((layer * 4 + order * 2 + 1) * 512 + c)) * L;
      for (int ch = tid; ch < (2 * L + 64) / 8; ch += NTHR) {
        const int i0 = ch * 8;
        uint4 o;
        if (i0 < L) {
          const uint4 v = *(const uint4*)(fp + (L - 8 - i0));
          o.x = (v.w >> 16) | (v.w << 16); o.y = (v.z >> 16) | (v.z << 16); o.z = (v.y >> 16) | (v.y << 16); o.w = (v.x >> 16) | (v.x << 16);
        } else {
          unsigned e8[8];
#pragma unroll
          for (int e = 0; e < 8; ++e) { const int i = i0 + e; e8[e] = i <= 2 * L - 2 ? (unsigned)fn[i - (L - 1)] : 0u; }
          o.x = e8[0] | (e8[1] << 16); o.y = e8[2] | (e8[3] << 16); o.z = e8[4] | (e8[5] << 16); o.w = e8[6] | (e8[7] << 16);
        }
        *(uint4*)(R + i0) = o;
      }
    }
    __syncthreads();
    if (active) {
      const int xcol = (order == 0 ? 512 : 1024) + c;
      const float w0 = sw[xcol], w1 = sw[1536 + xcol], w2 = sw[3072 + xcol], bb = sb[xcol];
      const float bias = p.hy_bias[(layer * 2 + order) * 512 + c];
      f32x16 acc[TPW];
#pragma unroll
      for (int j = 0; j < TPW; ++j)
#pragma unroll
        for (int i = 0; i < 16; ++i) acc[j][i] = 0.f;
      auto d1_range = [&](const int lo, const int hi, const int jmask) {
#pragma unroll 1
        for (int d1o = lo; d1o < hi; d1o += 2) {
#pragma unroll
          for (int dk = 0; dk < 4; ++dk) {
            const int d1 = d1o + (dk >> 1), ks = dk & 1;
            const unsigned* rp = Rd + (-16 * d1 + 8 * ks);
            unsigned w[5];
#pragma unroll
            for (int q = 0; q < 5; ++q) w[q] = rp[q];
            union { s16x8 v; unsigned u[4]; } af;
#pragma unroll
            for (int q = 0; q < 4; ++q) af.u[q] = __builtin_amdgcn_alignbit(w[q + 1], w[q], sh);
#pragma unroll
            for (int j = 0; j < TPW; ++j) {
              if (!((jmask >> (j & 1)) & 1)) continue;
              const bool ok = (unsigned)(tt1[j] - d1) < (unsigned)NB1;
              const int addr = ok ? ub[j] - d1 * 80 + ks * 32 : zaddr;
              const s16x8 bf = *(const s16x8*)(lds + addr);
              acc[j] = MFMA(af.v, bf, acc[j]);
            }
          }
        }
      };
      if (NB1 == 64) { d1_range(-64, -32, 1); d1_range(-32, 32, 3); d1_range(32, 64, 2); }
      else d1_range(-NB1, NB1, 3);
#pragma unroll
      for (int j = 0; j < TPW; ++j) {
        const u16* zr = zbase + ((size_t)(tb[j] * 1536 + xcol)) * L;
#pragma unroll
        for (int g4 = 0; g4 < 4; ++g4) {
          const int t0 = 8 * g4 + 4 * h, t = 32 * tt1[j] + t0;
          const int uidx = (tb[j] * NB1 + tt1[j]) * 40 + t0;
          const uint2 uu = *(const uint2*)(U + uidx);
          const uint2 zz = *(const uint2*)(zr + t);
          const float zm1 = t > 0 ? bf2f(zr[t - 1]) : 0.f;
          const float zp4 = t + 4 < L ? bf2f(zr[t + 4]) : 0.f;
          const float zv[6] = {zm1, bf2f((u16)(zz.x & 0xffff)), bf2f((u16)(zz.x >> 16)), bf2f((u16)(zz.y & 0xffff)), bf2f((u16)(zz.y >> 16)), zp4};
          const float uv[4] = {bf2f((u16)(uu.x & 0xffff)), bf2f((u16)(uu.x >> 16)), bf2f((u16)(uu.y & 0xffff)), bf2f((u16)(uu.y >> 16))};
          float yv[4];
#pragma unroll
          for (int e = 0; e < 4; ++e) {
            const float xv = w0 * zv[e] + w1 * zv[e + 1] + w2 * zv[e + 2] + bb;
            yv[e] = xv * (acc[j][4 * g4 + e] + bias * uv[e]);
          }
          if (order == 0) *(uint2*)(U + uidx) = make_uint2(pack2(yv[0], yv[1]), pack2(yv[2], yv[3]));
          else {
            const size_t row = NB1 == 64 ? (size_t)tb[j] * 2048 + t : (size_t)TL + tb[j] * 256 + t;
            u16* yo = (u16*)(wsb + OFF_Y) + row * 512 + c;
#pragma unroll
            for (int e = 0; e < 4; ++e) yo[(size_t)e * 512] = f2bf(yv[e]);
          }
        }
      }
    }
  }
}

template <int MODE>
DI void attn_wave(const u16* __restrict__ Q, const u16* __restrict__ K, const u16* __restrict__ Vt, u16* __restrict__ Yout,
                  int qpos0, const float* rpb, float sink, bool has_sink) {
  const int lane = TIDX & 63, r = lane & 31, h = lane >> 5;
  s16x8 qf[4];
#pragma unroll
  for (int ks = 0; ks < 4; ++ks) qf[ks] = *(const s16x8*)(Q + r * 64 + ks * 16 + h * 8);
  f32x16 O0, O1;
#pragma unroll
  for (int i = 0; i < 16; ++i) { O0[i] = 0.f; O1[i] = 0.f; }
  float mrun = -INFINITY, lrun = 0.f;
  int nloc = 0, jlo = 0, qr = 0, qc = 0, rs = 0;
  if (MODE == 0) {
    jlo = qpos0 < 128 ? (128 - qpos0) >> 5 : 0;
    const int jhi = min(8, (2047 - (qpos0 - 128)) >> 5);
    nloc = jhi - jlo + 1;
  } else if (MODE == 1) {
    qr = qpos0 >> 6; qc = (qpos0 & 63) + r; rs = min(max(qr - 4, 0), 24); nloc = 16;
  }
  const int ntiles = 8 + nloc;
  auto tile_kb = [&](int i) -> int {
    if (i < 8) return 2048 + i * 32;
    const int j = i - 8;
    if (MODE == 0) return qpos0 - 128 + 32 * (jlo + j);
    return (rs + (j >> 1)) * 64 + 32 * (j & 1);
  };
  const u16* kbase = K + (size_t)r * 64 + h * 8;
  const u16* vbase = Vt + (size_t)r * 2304 + 4 * h;
  s16x8 kf[4];
  {
    const int kb = tile_kb(0);
#pragma unroll
    for (int ks = 0; ks < 4; ++ks) kf[ks] = *(const s16x8*)(kbase + (size_t)kb * 64 + ks * 16);
  }
#pragma unroll 1
  for (int i = 0; i < ntiles; ++i) {
    const int kb = tile_kb(i);
    union { s16x8 v; uint2 u[2]; } v0[2], v1[2];
#pragma unroll
    for (int s2 = 0; s2 < 2; ++s2) {
      const u16* vp0 = vbase + kb + 16 * s2;
      const u16* vp1 = vp0 + (size_t)32 * 2304;
      v0[s2].u[0] = *(const uint2*)vp0; v0[s2].u[1] = *(const uint2*)(vp0 + 8);
      v1[s2].u[0] = *(const uint2*)vp1; v1[s2].u[1] = *(const uint2*)(vp1 + 8);
    }
    s16x8 kn[4];
    {
      const int kbn = tile_kb(i + 1 < ntiles ? i + 1 : i);
#pragma unroll
      for (int ks = 0; ks < 4; ++ks) kn[ks] = *(const s16x8*)(kbase + (size_t)kbn * 64 + ks * 16);
    }
    f32x16 S;
#pragma unroll
    for (int q = 0; q < 16; ++q) S[q] = 0.f;
#pragma unroll
    for (int ks = 0; ks < 4; ++ks) S = MFMA(kf[ks], qf[ks], S);
    if (i >= 8) {
      if (MODE == 0) {
        const int d0 = (qpos0 + r) - (kb + 4 * h);
#pragma unroll
        for (int reg = 0; reg < 16; ++reg) { const int d = d0 - ((reg & 3) + 8 * (reg >> 2)); if (d > 128 || d < -128) S[reg] = -INFINITY; }
      } else if (MODE == 1) {
        const int j = i - 8;
        const float* brow = rpb + ((rs + (j >> 1)) - qr + 7) * 160 + 64;
        const int cstart = min(max(qc - 8, 0), 48);
        const int kc0 = 32 * (j & 1) + 4 * h;
        const float* bp = brow + (kc0 - qc + 15);
        const int rel = kc0 - cstart;
#pragma unroll
        for (int reg = 0; reg < 16; ++reg) {
          const int o = (reg & 3) + 8 * (reg >> 2);
          const bool ok = (unsigned)(rel + o) < 16u;
          S[reg] = ok ? S[reg] + bp[o] : -INFINITY;
        }
      }
    }
    float mx = S[0];
#pragma unroll
    for (int reg = 1; reg < 16; ++reg) mx = fmaxf(mx, S[reg]);
    mx = fmaxf(mx, __shfl_xor(mx, 32));
    const float mnew = fmaxf(mrun, mx);
    const float alpha = __expf(mrun - mnew);
    float ps = 0.f;
#pragma unroll
    for (int reg = 0; reg < 16; ++reg) { S[reg] = __expf(S[reg] - mnew); ps += S[reg]; }
    lrun = lrun * alpha + ps;
    mrun = mnew;
#pragma unroll
    for (int q = 0; q < 16; ++q) { O0[q] *= alpha; O1[q] *= alpha; }
#pragma unroll
    for (int s2 = 0; s2 < 2; ++s2) {
      union { s16x8 v; unsigned u[4]; } pf;
#pragma unroll
      for (int q = 0; q < 4; ++q) pf.u[q] = pack2(S[8 * s2 + 2 * q], S[8 * s2 + 2 * q + 1]);
      O0 = MFMA(v0[s2].v, pf.v, O0);
      O1 = MFMA(v1[s2].v, pf.v, O1);
    }
#pragma unroll
    for (int ks = 0; ks < 4; ++ks) kf[ks] = kn[ks];
  }
  float lt = lrun + __shfl_xor(lrun, 32);
  if (has_sink) lt += __expf(sink - mrun);
  const float inv = 1.f / lt;
  u16* yo = Yout + (size_t)r * 512;
#pragma unroll
  for (int g4 = 0; g4 < 4; ++g4) {
    *(uint2*)(yo + 8 * g4 + 4 * h) = make_uint2(pack2(O0[4 * g4] * inv, O0[4 * g4 + 1] * inv), pack2(O0[4 * g4 + 2] * inv, O0[4 * g4 + 3] * inv));
    *(uint2*)(yo + 32 + 8 * g4 + 4 * h) = make_uint2(pack2(O1[4 * g4] * inv, O1[4 * g4 + 1] * inv), pack2(O1[4 * g4 + 2] * inv, O1[4 * g4 + 3] * inv));
  }
}

constexpr int AT_BUF = 8192 + 64 * 136;
DI void attn_stage_k(const u16* __restrict__ K, int kb, char* buf, int tid) {
#pragma unroll
  for (int i = 0; i < 2; ++i) {
    const int S = tid + NTHR * i, row = S >> 3, c = (S & 7) ^ ((row >> 1) & 7);
    __builtin_amdgcn_global_load_lds((const unsigned*)(K + (size_t)(kb + row) * 64 + c * 8), (__attribute__((address_space(3))) unsigned*)(buf + S * 16), 16, 0, 0);
  }
}
template <int MODE>
DI void attn_block(const u16* __restrict__ Q, const u16* __restrict__ K, const u16* __restrict__ Vt, u16* __restrict__ Yout,
                   int qpos0, int blk_lo, int blk_n, int w_lo, const float* rpb, float sink, bool has_sink, char* lds) {
  const int tid = TIDX, lane = tid & 63, r = lane & 31, h = lane >> 5;
  s16x8 qf[4];
#pragma unroll
  for (int ks = 0; ks < 4; ++ks) qf[ks] = *(const s16x8*)(Q + r * 64 + ks * 16 + h * 8);
  f32x16 O0, O1;
#pragma unroll
  for (int i = 0; i < 16; ++i) { O0[i] = 0.f; O1[i] = 0.f; }
  float mrun = -INFINITY, lrun = 0.f;
  const int nloc = MODE == 0 ? (blk_n + 1) >> 1 : (MODE == 1 ? blk_n : 0);
  const int nst = 4 + nloc;
  auto step_kb = [&](int st) -> int {
    if (st < 4) return 2048 + st * 64;
    return MODE == 0 ? blk_lo + 64 * (st - 4) : (blk_lo + (st - 4)) * 64;
  };
  typedef __attribute__((ext_vector_type(4))) unsigned u32x4;
  const int vd = tid >> 3, vc = (tid & 7) * 8;
  const int kwofs = vd * 128 + (((tid & 7) ^ ((vd >> 1) & 7)) << 4);
  u32x4 kp[2], vp[2], kq[2], vq[2];
  const int sw = (r >> 1) & 7;
  const int qr = qpos0 >> 6, qc = (qpos0 & 63) + r;
#define AT_LOAD(KR, VR, ST) do { const int kb_ = step_kb((ST) < nst ? (ST) : nst - 1); \
    _Pragma("unroll") for (int i = 0; i < 2; ++i) { KR[i] = *(const u32x4*)(K + (size_t)(kb_ + vd + 32 * i) * 64 + vc); \
                                                    VR[i] = *(const u32x4*)(Vt + (size_t)(vd + 32 * i) * 2304 + kb_ + vc); } } while (0)
#define AT_STORE(KR, VR, BUF) do { _Pragma("unroll") for (int i = 0; i < 2; ++i) { *(u32x4*)((BUF) + kwofs + i * 4096) = KR[i]; \
    char* vp_ = (BUF) + 8192 + (vd + 32 * i) * 136 + vc * 2; \
    *(uint2*)vp_ = make_uint2(VR[i][0], VR[i][1]); *(uint2*)(vp_ + 8) = make_uint2(VR[i][2], VR[i][3]); } } while (0)
  auto compute = [&](const int st, const char* cur) {
    const int kb = step_kb(st);
    bool wave_on = true;
    if (MODE == 1 && st >= 4) { const int rr = blk_lo + (st - 4); wave_on = rr >= w_lo && rr < w_lo + 8; }
    if (wave_on) {
#pragma unroll
      for (int th = 0; th < 2; ++th) {
        if (MODE == 0 && st >= 4 && 2 * (st - 4) + th >= blk_n) continue;
        f32x16 S;
#pragma unroll
        for (int q = 0; q < 16; ++q) S[q] = 0.f;
#pragma unroll
        for (int ks = 0; ks < 4; ++ks) {
          const s16x8 kf = *(const s16x8*)(cur + (th * 32 + r) * 128 + (((ks * 2 + h) ^ sw) << 4));
          S = MFMA(kf, qf[ks], S);
        }
        if (st >= 4) {
          if (MODE == 0) {
            const int d0 = (qpos0 + r) - (kb + 32 * th + 4 * h);
#pragma unroll
            for (int reg = 0; reg < 16; ++reg) { const int d = d0 - ((reg & 3) + 8 * (reg >> 2)); if (d > 128 || d < -128) S[reg] = -INFINITY; }
          } else if (MODE == 1) {
            const int rr = blk_lo + (st - 4);
            const float* brow = rpb + (rr - qr + 7) * 160 + 64;
            const int cstart = min(max(qc - 8, 0), 48);
            const int kc0 = 32 * th + 4 * h;
            const float* bp = brow + (kc0 - qc + 15);
            const int rel = kc0 - cstart;
#pragma unroll
            for (int reg = 0; reg < 16; ++reg) {
              const int o = (reg & 3) + 8 * (reg >> 2);
              const bool ok = (unsigned)(rel + o) < 16u;
              const float tb = S[reg] + bp[o];
              S[reg] = ok ? tb : -INFINITY;
            }
          }
        }
        float mx = S[0];
#pragma unroll
        for (int reg = 1; reg < 16; ++reg) mx = fmaxf(mx, S[reg]);
        mx = fmaxf(mx, __shfl_xor(mx, 32));
        const float mnew = fmaxf(mrun, mx);
        const float alpha = __expf(mrun - mnew);
        float ps = 0.f;
#pragma unroll
        for (int reg = 0; reg < 16; ++reg) { S[reg] = __expf(S[reg] - mnew); ps += S[reg]; }
        lrun = lrun * alpha + ps;
        mrun = mnew;
#pragma unroll
        for (int q = 0; q < 16; ++q) { O0[q] *= alpha; O1[q] *= alpha; }
#pragma unroll
        for (int s2 = 0; s2 < 2; ++s2) {
          union { s16x8 v; unsigned u[4]; } pf;
#pragma unroll
          for (int q = 0; q < 4; ++q) pf.u[q] = pack2(S[8 * s2 + 2 * q], S[8 * s2 + 2 * q + 1]);
          union { s16x8 v; uint2 u[2]; } v0, v1;
          const char* vp0 = cur + 8192 + r * 136 + (32 * th + 16 * s2 + 4 * h) * 2;
          const char* vp1 = vp0 + 32 * 136;
          v0.u[0] = *(const uint2*)vp0; v0.u[1] = *(const uint2*)(vp0 + 16);
          v1.u[0] = *(const uint2*)vp1; v1.u[1] = *(const uint2*)(vp1 + 16);
          O0 = MFMA(v0.v, pf.v, O0);
          O1 = MFMA(v1.v, pf.v, O1);
        }
      }
    }
  };
  char* buf0 = lds;
  char* buf1 = lds + AT_BUF;
  AT_LOAD(kp, vp, 0);
  AT_STORE(kp, vp, buf0);
  AT_LOAD(kp, vp, 1);
  __syncthreads();
#pragma unroll 1
  for (int st = 0; st < nst; st += 2) {
    AT_LOAD(kq, vq, st + 2);
    __builtin_amdgcn_sched_barrier(0);
    compute(st, buf0);
    AT_STORE(kp, vp, buf1);
    __syncthreads();
    if (st + 1 < nst) {
      AT_LOAD(kp, vp, st + 3);
      __builtin_amdgcn_sched_barrier(0);
      compute(st + 1, buf1);
      AT_STORE(kq, vq, buf0);
      __syncthreads();
    }
  }
#undef AT_LOAD
#undef AT_STORE
  float lt = lrun + __shfl_xor(lrun, 32);
  if (has_sink) lt += __expf(sink - mrun);
  const float inv = 1.f / lt;
  u16* yo = Yout + (size_t)r * 512;
#pragma unroll
  for (int g4 = 0; g4 < 4; ++g4) {
    *(uint2*)(yo + 8 * g4 + 4 * h) = make_uint2(pack2(O0[4 * g4] * inv, O0[4 * g4 + 1] * inv), pack2(O0[4 * g4 + 2] * inv, O0[4 * g4 + 3] * inv));
    *(uint2*)(yo + 32 + 8 * g4 + 4 * h) = make_uint2(pack2(O1[4 * g4] * inv, O1[4 * g4 + 1] * inv), pack2(O1[4 * g4 + 2] * inv, O1[4 * g4 + 3] * inv));
  }
}

DI void phase_mix(const Params& p, char* wsb, int layer, char* lds) {
  const bool upd = layer < 3;
  const int n_hl = 512, n_swa = 1024, n_na = 1024, n_ca = upd ? 256 : 0, n_hc = upd ? 512 : 0;
  const int total = n_hl + n_swa + n_na + n_ca + n_hc;
  const int wid = TIDX >> 6;
  u16* Y = (u16*)(wsb + OFF_Y);
  const u16* QS = (const u16*)(wsb + OFF_QS);
  const u16* KS = (const u16*)(wsb + OFF_KS);
  const u16* VTS = (const u16*)(wsb + OFF_VTS);
  const u16* QN = (const u16*)(wsb + OFF_QN);
  const u16* KN = (const u16*)(wsb + OFF_KN);
  const u16* VTN = (const u16*)(wsb + OFF_VTN);
  const int nmine = (total - (int)blockIdx.x + (int)gridDim.x - 1) / (int)gridDim.x;
  const bool rev = blockIdx.x >= (gridDim.x >> 1);
#pragma unroll 1
  for (int q = 0; q < nmine; ++q) {
    const int it = (int)blockIdx.x + (rev ? nmine - 1 - q : q) * (int)gridDim.x;
    int t = it;
    __syncthreads();
    if (t < n_hl) { const int ch = (t & 7) * 64 + (t >> 3); REP(9) { __syncthreads(); hyena_item<64>(p, wsb, layer, ch, lds); } continue; }
    t -= n_hl;
    if (t < n_swa) { REP(10) {
      const int b = t >> 7, kvh = (t >> 6) & 1, qt = t & 63, head = kvh * 4 + wid;
      const int q0 = qt * 32;
      const int lo = max(q0 - 128, 0), hi = min(q0 + 128, 2016);
      __syncthreads();
      if (!(ATT_NEW & 1)) attn_wave<0>(QS + ((size_t)(b * 8 + head) * 2304 + q0) * 64, KS + (size_t)(b * 2 + kvh) * 2304 * 64, VTS + (size_t)(b * 2 + kvh) * 64 * 2304,
                   Y + ((size_t)1 * TT + (size_t)b * 2048 + q0) * 512 + head * 64, q0, nullptr, p.swa_sink[layer * 8 + head], true);
      else attn_block<0>(QS + ((size_t)(b * 8 + head) * 2304 + q0) * 64, KS + (size_t)(b * 2 + kvh) * 2304 * 64, VTS + (size_t)(b * 2 + kvh) * 64 * 2304,
                    Y + ((size_t)1 * TT + (size_t)b * 2048 + q0) * 512 + head * 64, q0, lo, ((hi - lo) >> 5) + 1, 0, nullptr, p.swa_sink[layer * 8 + head], true, lds); }
      continue;
    }
    t -= n_swa;
    if (t < n_na) { REP(10) {
      const int b = t >> 7, head = (t >> 4) & 7, rp = t & 15;
      const int row = rp * 2 + (wid >> 1);
      const int q0 = row * 64 + (wid & 1) * 32;
      const int rs0 = min(max(2 * rp - 4, 0), 24), rs1 = min(max(2 * rp + 1 - 4, 0), 24);
      __syncthreads();
      if (!(ATT_NEW & 2)) attn_wave<1>(QN + ((size_t)(b * 8 + head) * 2304 + q0) * 64, KN + (size_t)(b * 8 + head) * 2304 * 64, VTN + (size_t)(b * 8 + head) * 64 * 2304,
                   Y + ((size_t)2 * TT + (size_t)b * 2048 + q0) * 512 + head * 64, q0, (const float*)(wsb + OFF_RPB) + (size_t)(layer * 8 + head) * 15 * 160, 0.f, false);
      else attn_block<1>(QN + ((size_t)(b * 8 + head) * 2304 + q0) * 64, KN + (size_t)(b * 8 + head) * 2304 * 64, VTN + (size_t)(b * 8 + head) * 64 * 2304,
                    Y + ((size_t)2 * TT + (size_t)b * 2048 + q0) * 512 + head * 64, q0, rs0, rs1 - rs0 + 8, min(max(row - 4, 0), 24),
                    (const float*)(wsb + OFF_RPB) + (size_t)(layer * 8 + head) * 15 * 160, 0.f, false, lds); }
      continue;
    }
    t -= n_na;
    if (t < n_ca) {
      const int b = t >> 5, h16 = (t >> 1) & 15, qt = (t & 1) * 4 + wid;
      const int q0 = 2048 + qt * 32;
      if (h16 < 8) {
        const int head = h16, kvh = head >> 2;
        if (!(ATT_NEW & 4)) attn_wave<2>(QS + ((size_t)(b * 8 + head) * 2304 + q0) * 64, KS + (size_t)(b * 2 + kvh) * 2304 * 64, VTS + (size_t)(b * 2 + kvh) * 64 * 2304,
                     Y + ((size_t)1 * TT + (size_t)TL + b * 256 + qt * 32) * 512 + head * 64, 0, nullptr, p.swa_sink[layer * 8 + head], true);
        else attn_block<2>(QS + ((size_t)(b * 8 + head) * 2304 + q0) * 64, KS + (size_t)(b * 2 + kvh) * 2304 * 64, VTS + (size_t)(b * 2 + kvh) * 64 * 2304,
                      Y + ((size_t)1 * TT + (size_t)TL + b * 256 + qt * 32) * 512 + head * 64, 0, 0, 0, 0, nullptr, p.swa_sink[layer * 8 + head], true, lds);
      } else {
        const int head = h16 - 8;
        if (!(ATT_NEW & 4)) attn_wave<2>(QN + ((size_t)(b * 8 + head) * 2304 + q0) * 64, KN + (size_t)(b * 8 + head) * 2304 * 64, VTN + (size_t)(b * 8 + head) * 64 * 2304,
                     Y + ((size_t)2 * TT + (size_t)TL + b * 256 + qt * 32) * 512 + head * 64, 0, nullptr, 0.f, false);
        else attn_block<2>(QN + ((size_t)(b * 8 + head) * 2304 + q0) * 64, KN + (size_t)(b * 8 + head) * 2304 * 64, VTN + (size_t)(b * 8 + head) * 64 * 2304,
                      Y + ((size_t)2 * TT + (size_t)TL + b * 256 + qt * 32) * 512 + head * 64, 0, 0, 0, 0, nullptr, 0.f, false, lds);
      }
      continue;
    }
    t -= n_ca;
    hyena_item<8>(p, wsb, layer, (t & 7) * 64 + (t >> 3), lds);
  }
}

__global__ void __launch_bounds__(NTHR, 2) fwd_megakernel(Params p0) {
  __shared__ __attribute__((aligned(16))) char lds[65536];
  cg::grid_group grid = cg::this_grid();
  __shared__ uint4 xb_words;
  if (threadIdx.x == 0) xb_words = make_uint4(0u, 0u, 0u, 0u);
  __syncthreads();
  const XcdBarrier xb = xcd_barrier_post((unsigned*)(p0.ws + OFF_BAR), (volatile LAS unsigned*)&xb_words);
  REP(8) { unsigned zo = 0; asm volatile("" : "+s"(zo)); char* wsl = p0.ws + zo; phase_prep(p0, wsl, lds); }
  if (p0.out == nullptr) grid.sync();
  xcd_barrier(xb);
  { unsigned zo = 0; asm volatile("" : "+s"(zo)); char* wsl = p0.ws + zo; phase_mods_reduce(p0, wsl); }
  xcd_barrier(xb);
  for (int layer = 0; layer < 4; ++layer) {
    const bool last = layer == 3;
    const int mr2 = last ? TL : TT;
    REP(4) { unsigned zo = 0; asm volatile("" : "+s"(zo)); char* wsl = p0.ws + zo; phase_norm(p0, wsl, layer, 0, TT, true, lds); }
    REP(5) xcd_barrier(xb);
    REP(1) { unsigned zo = 0; asm volatile("" : "+s"(zo)); char* wsl = p0.ws + zo; phase_gu(p0, wsl, 0, TT, lds); }
    REP(5) xcd_barrier(xb);
    { unsigned zo = 0; asm volatile("" : "+s"(zo)); char* wsl = p0.ws + zo; phase_dn(p0, wsl, layer, 0, TT, false, lds); }
    REP(5) xcd_barrier(xb);
    REP(4) { unsigned zo = 0; asm volatile("" : "+s"(zo)); char* wsl = p0.ws + zo; phase_norm(p0, wsl, layer, 1, TT, false, lds); }
    REP(5) xcd_barrier(xb);
    REP(2) { unsigned zo = 0; asm volatile("" : "+s"(zo)); char* wsl = p0.ws + zo; phase_in(p0, wsl, layer, lds); }
    REP(5) xcd_barrier(xb);
    REP(3) { unsigned zo = 0; asm volatile("" : "+s"(zo)); char* wsl = p0.ws + zo; phase_mix(p0, wsl, layer, lds); }
    REP(5) xcd_barrier(xb);
    REP(7) { unsigned zo = 0; asm volatile("" : "+s"(zo)); char* wsl = p0.ws + zo; phase_m1(p0, wsl, mr2, lds); }
    REP(5) xcd_barrier(xb);
    { unsigned zo = 0; asm volatile("" : "+s"(zo)); char* wsl = p0.ws + zo; phase_m2(p0, wsl, layer, mr2, lds); }
    REP(5) xcd_barrier(xb);
    REP(4) { unsigned zo = 0; asm volatile("" : "+s"(zo)); char* wsl = p0.ws + zo; phase_norm(p0, wsl, layer, 2, mr2, false, lds); }
    REP(5) xcd_barrier(xb);
    REP(1) { unsigned zo = 0; asm volatile("" : "+s"(zo)); char* wsl = p0.ws + zo; phase_gu(p0, wsl, 1, mr2, lds); }
    REP(5) xcd_barrier(xb);
    { unsigned zo = 0; asm volatile("" : "+s"(zo)); char* wsl = p0.ws + zo; phase_dn(p0, wsl, layer, 1, mr2, last, lds); }
    if (!last) { REP(5) xcd_barrier(xb); }
  }
}

extern "C" void kernel_launch(void* const* d_in, const int* in_sizes, int n_in, void* d_out, int out_size, void* d_ws,
                              size_t ws_size, hipStream_t stream) {
  static int grid_blocks = 0;
  if (!grid_blocks) {
    int dev = 0, cus = 0, per_cu = 0;
    hipGetDevice(&dev);
    hipDeviceGetAttribute(&cus, hipDeviceAttributeMultiprocessorCount, dev);
    hipOccupancyMaxActiveBlocksPerMultiprocessor(&per_cu, fwd_megakernel, NTHR, 0);
    if (per_cu > 2) per_cu = 2;
    if (per_cu < 1) per_cu = 1;
    grid_blocks = (cus * per_cu) & ~7;
  }
  if (ws_size < WS_NEED) { fprintf(stderr, "workspace too small: %zu < %zu\n", ws_size, WS_NEED); return; }
  Params p{};
  const float** f = (const float**)&p;
  for (int i = 0; i < 30; ++i) f[i] = (const float*)d_in[i];
  p.out = (float*)d_out;
  p.ws = (char*)d_ws;
  hipMemsetAsync(d_ws, 0, 16384, stream);
  void* args[] = {&p};
  hipError_t e = hipLaunchCooperativeKernel((void*)fwd_megakernel, dim3(grid_blocks), dim3(NTHR), args, 0, stream);
  if (e != hipSuccess) fprintf(stderr, "cooperative launch failed: %s (grid %d)\n", hipGetErrorString(e), grid_blocks);
}
```

```cpp
#include <hip/hip_runtime.h>
#include <hip/hip_cooperative_groups.h>
#include <cstdio>
namespace cg = cooperative_groups;

typedef unsigned short u16;
typedef __attribute__((ext_vector_type(8))) short s16x8;
typedef __attribute__((ext_vector_type(16))) float f32x16;
#define DI __device__ __forceinline__
typedef float f32x4v __attribute__((ext_vector_type(4)));
#define NT_LD4(ptr) __builtin_nontemporal_load((const f32x4v*)(ptr))
#define MFMA(a, b, c) __builtin_amdgcn_mfma_f32_32x32x16_bf16((a), (b), (c), 0, 0, 0)

constexpr int TL = 16384, TC = 2048, TT = 18432;
constexpr int NTHR = 256;
#ifndef PROBE
#define PROBE 0
#endif
#ifndef ATT_NEW
#define ATT_NEW 3
#endif
#define REP(k) for (int rep_ = 0; rep_ < (PROBE == (k) ? 2 : 1); ++rep_)

constexpr size_t OFF_BAR  = 0;
constexpr size_t OFF_MODS = 16384;
constexpr size_t SZ_MODS  = (size_t)4 * 9 * 9216 * 4;
constexpr size_t OFF_MODP = OFF_MODS + SZ_MODS;
constexpr size_t OFF_ROPE = OFF_MODP + 8 * SZ_MODS;
constexpr size_t OFF_RPB  = OFF_ROPE + 16384;
constexpr size_t OFF_FL   = OFF_RPB + 307200;
constexpr size_t OFF_FC   = OFF_FL + (size_t)4 * 4 * 512 * 2048 * 2;
constexpr size_t OFF_XS   = OFF_FC + (size_t)4 * 4 * 512 * 256 * 2;
constexpr size_t OFF_H    = OFF_XS + (size_t)TT * 1024 * 4;
constexpr size_t OFF_Z    = OFF_H + (size_t)TT * 1024 * 2;
constexpr size_t OFF_ZH   = OFF_Z;
constexpr size_t OFF_ZHC  = OFF_ZH + (size_t)8 * 1536 * 2048 * 2;
constexpr size_t OFF_QS   = OFF_ZHC + (size_t)8 * 1536 * 256 * 2;
constexpr size_t OFF_KS   = OFF_QS + (size_t)8 * 8 * 2304 * 64 * 2;
constexpr size_t OFF_VTS  = OFF_KS + (size_t)8 * 2 * 2304 * 64 * 2;
constexpr size_t OFF_QN   = OFF_VTS + (size_t)8 * 2 * 2304 * 64 * 2;
constexpr size_t OFF_KN   = OFF_QN + (size_t)8 * 8 * 2304 * 64 * 2;
constexpr size_t OFF_VTN  = OFF_KN + (size_t)8 * 8 * 2304 * 64 * 2;
constexpr size_t OFF_GATE = OFF_VTN + (size_t)8 * 8 * 2304 * 64 * 2;
constexpr size_t OFF_HID  = OFF_Z;
constexpr size_t OFF_Y    = OFF_GATE + (size_t)TT * 3072 * 2;
constexpr size_t OFF_W    = OFF_Y + (size_t)3 * TT * 512 * 2;
constexpr size_t W_GU0 = 0, W_D0 = 5767168, W_GU1 = 8650752, W_D1 = 14417920, W_IN = 17301504, W_B = 24379392, W_O = 25952256, W_END = 27000832;
constexpr size_t WS_NEED  = OFF_W + W_END * 2;

struct Params {
  const float *x, *c, *ctx, *c_ctx, *w_ada, *b_ada, *norm_g, *ffn_wg, *ffn_wu, *ffn_wd, *w_in,
      *hy_short_w, *hy_short_b, *pe_w0, *pe_b0, *pe_w1, *pe_b1, *pe_w2, *pe_b2, *pe_wout, *sin_freq, *hy_bias,
      *swa_qg, *swa_kg, *swa_sink, *na_qg, *na_kg, *na_rpb, *w_branch, *w_out;
  float* out;
  char* ws;
};

DI int opaque_tid() { int t = threadIdx.x; asm volatile("" : "+v"(t)); return t; }
#define TIDX opaque_tid()
#define GAS __attribute__((address_space(1)))
template <class T>
DI GAS T* uptr(T* p) {
  const unsigned long long v = (unsigned long long)p;
  const unsigned lo = __builtin_amdgcn_readfirstlane((unsigned)v), hi = __builtin_amdgcn_readfirstlane((unsigned)(v >> 32));
  return (GAS T*)(((unsigned long long)hi << 32) | lo);
}
DI int opaque0() { int z = 0; asm volatile("" : "+v"(z)); return z; }
typedef __bf16 bf16x2_t __attribute__((ext_vector_type(2)));
DI u16 f2bf(float x) { return __builtin_bit_cast(u16, (__bf16)x); }
DI float bf2f(u16 v) { return __uint_as_float(((unsigned)v) << 16); }
DI unsigned pack2(float a, float b) { bf16x2_t v = {(__bf16)a, (__bf16)b}; return __builtin_bit_cast(unsigned, v); }
DI int crow(int reg, int h) { return (reg & 3) + 8 * (reg >> 2) + 4 * h; }
DI float sigmoidf_(float x) { return __builtin_amdgcn_rcpf(1.f + __expf(-x)); }

#define XB_TMO      128
#define XB_XCNT(j)  (256  + 64 * (j))
#define XB_XSUB(j)  (1280 + 64 * (j))
#define XB_XGEN(j)  (2304 + 64 * (j))
#define XB_TOP      3328
#define XB_TOPGEN   3392
#define XCD_BAR_WORDS 3456
#define XB_SPIN_CAP (1u << 22)
#define LAS __attribute__((address_space(3)))
DI unsigned xb_ld(unsigned* p) { return __hip_atomic_load(p, __ATOMIC_RELAXED, __HIP_MEMORY_SCOPE_AGENT); }
DI unsigned xb_add(unsigned* p, unsigned v) { return __hip_atomic_fetch_add(p, v, __ATOMIC_RELAXED, __HIP_MEMORY_SCOPE_AGENT); }
DI unsigned xb_xcc_id() { return (unsigned)__builtin_amdgcn_s_getreg((3 << 11) | 20) & 0xFu; }
#define XB_SPIN(cond, bar) do { unsigned _sp = 0; while (cond) { __builtin_amdgcn_s_sleep(1); \
    if ((++_sp & 255u) == 0u) { if (xb_ld(&(bar)[XB_TMO])) break; if (_sp > XB_SPIN_CAP) { atomicAdd(&(bar)[XB_TMO], 1u); break; } } } } while (0)
struct XcdBarrier { unsigned* bar; unsigned x; volatile LAS unsigned* st; };
DI XcdBarrier xcd_barrier_post(unsigned* bar, volatile LAS unsigned* st) {
  XcdBarrier b; b.bar = bar; b.x = xb_xcc_id(); b.st = st;
  if (threadIdx.x == 0) (void)xb_add(&bar[XB_XCNT(b.x)], 1u);
  return b;
}
DI void xcd_barrier_complete(unsigned* bar, unsigned x, unsigned& nloc, unsigned& nx) {
  const unsigned G = gridDim.x;
  unsigned sum, cnt, mine, sp = 0u;
  for (;;) {
    sum = 0u; cnt = 0u; mine = 0u;
#pragma unroll
    for (unsigned j = 0; j < 16; ++j) { const unsigned c = xb_ld(&bar[XB_XCNT(j)]); sum += c; cnt += (c > 0u) ? 1u : 0u; mine = (j == x) ? c : mine; }
    if (sum == G) break;
    __builtin_amdgcn_s_sleep(1);
    if ((++sp & 255u) == 0u) { if (xb_ld(&bar[XB_TMO])) break; if (sp > XB_SPIN_CAP) { atomicAdd(&bar[XB_TMO], 1u); break; } }
  }
  nloc = mine > 0u ? mine : 1u; nx = cnt > 0u ? cnt : 1u;
}
DI void xcd_barrier(const XcdBarrier& b) {
  asm volatile("s_waitcnt vmcnt(0)" ::: "memory");
  __syncthreads();
  if (threadIdx.x == 0) {
    unsigned* bar = b.bar;
    __builtin_amdgcn_s_waitcnt(0);
    unsigned nloc = b.st[0], nx = b.st[1];
    if (nloc == 0u) { xcd_barrier_complete(bar, b.x, nloc, nx); b.st[0] = nloc; b.st[1] = nx; }
    const unsigned old = xb_add(&bar[XB_XSUB(b.x)], 1u);
    const unsigned gen = old / nloc;
    if (old + 1u == (gen + 1u) * nloc) {
      __builtin_amdgcn_fence(__ATOMIC_RELEASE, "agent");
      asm volatile("s_waitcnt vmcnt(0)" ::: "memory");
      const unsigned og = xb_add(&bar[XB_TOP], 1u);
      const unsigned tg = og / nx;
      if (og + 1u == (tg + 1u) * nx) xb_add(&bar[XB_TOPGEN], 1u);
      else XB_SPIN(xb_ld(&bar[XB_TOPGEN]) == tg, bar);
      __builtin_amdgcn_fence(__ATOMIC_ACQUIRE, "agent");
      xb_add(&bar[XB_XGEN(b.x)], 1u);
      asm volatile("s_waitcnt vmcnt(0)" ::: "memory");
    } else {
      XB_SPIN(xb_ld(&bar[XB_XGEN(b.x)]) == gen, bar);
      __builtin_amdgcn_fence(__ATOMIC_ACQUIRE, "agent");
      asm volatile("s_waitcnt vmcnt(0)" ::: "memory");
    }
  }
  __syncthreads();
}

DI void mods_partial(const Params& p, char* wsb, int it, char* lds) {
  const int tid = TIDX;
  const int layer = it / 72, rem = it % 72, cgp = rem >> 3, kc = rem & 7;
  float* s = (float*)lds;
  for (int i = tid; i < 9 * 128; i += NTHR) {
    int r = i >> 7, k = kc * 128 + (i & 127);
    float v = r < 8 ? p.c[r * 1024 + k] : p.c_ctx[k];
    s[i] = v / (1.f + __expf(-v));
  }
  __syncthreads();
  const float* w = p.w_ada + (size_t)layer * 1024 * 9216 + (size_t)(kc * 128) * 9216 + cgp * 1024 + tid * 4;
  float acc[9][4];
#pragma unroll
  for (int r = 0; r < 9; ++r) { acc[r][0] = acc[r][1] = acc[r][2] = acc[r][3] = 0.f; }
#pragma unroll 4
  for (int k = 0; k < 128; ++k) {
    const f32x4v wq = NT_LD4(w + (size_t)k * 9216);
    const float4 wv = make_float4(wq[0], wq[1], wq[2], wq[3]);
#pragma unroll
    for (int r = 0; r < 9; ++r) {
      float sv = s[r * 128 + k];
      acc[r][0] += sv * wv.x; acc[r][1] += sv * wv.y; acc[r][2] += sv * wv.z; acc[r][3] += sv * wv.w;
    }
  }
  float* mp = (float*)(wsb + OFF_MODP);
#pragma unroll
  for (int r = 0; r < 9; ++r) {
    float4 o = make_float4(acc[r][0], acc[r][1], acc[r][2], acc[r][3]);
    *(float4*)(mp + ((size_t)((kc * 4 + layer) * 9 + r)) * 9216 + cgp * 1024 + tid * 4) = o;
  }
  __syncthreads();
}

DI void mlp_layer(const float* in, int in_ld, int nin, float* outp, const float* w, const float* bias, const float* freq) {
  const int tid = TIDX, lag = tid >> 3, fg = tid & 7;
  float a8[8];
#pragma unroll
  for (int q = 0; q < 8; ++q) a8[q] = bias[fg * 8 + q];
#pragma unroll 2
  for (int e = 0; e < nin; ++e) {
    float zv = in[lag * in_ld + e];
#pragma unroll
    for (int q = 0; q < 8; ++q) a8[q] += zv * w[e * 64 + fg * 8 + q];
  }
#pragma unroll
  for (int q = 0; q < 8; ++q) outp[lag * 64 + fg * 8 + q] = sinf(freq[fg * 8 + q] * a8[q]);
}

DI void filter_item(const Params& p, char* wsb, int it, char* lds) {
  const int tid = TIDX;
  const int layer = it / 72, ch = it % 72;
  const bool lat = ch < 64;
  const int L = lat ? 2048 : 256;
  const int l0 = lat ? ch * 32 : (ch - 64) * 32;
  float* zs = (float*)lds;
  float* a0 = zs + 32 * 34;
  float* a1 = a0 + 2048;
  {
    int lag = tid >> 3, j = tid & 7, l = l0 + lag;
    float wl = (6.283185307179586f / (float)L) * (float)l;
#pragma unroll
    for (int q = 0; q < 2; ++q) {
      int e = 2 * j + q;
      float f = 1e-4f + (float)e * ((15.f - 1e-4f) / 15.f);
      zs[lag * 34 + 1 + e] = cosf(f * wl);
      zs[lag * 34 + 17 + e] = -sinf(f * wl);
    }
    if (j == 0) zs[lag * 34] = (float)l / (float)(L - 1);
  }
  __syncthreads();
  const float* freq = p.sin_freq + layer * 64;
  mlp_layer(zs, 34, 33, a0, p.pe_w0 + layer * 33 * 64, p.pe_b0 + layer * 64, freq);
  __syncthreads();
  mlp_layer(a0, 64, 64, a1, p.pe_w1 + layer * 64 * 64, p.pe_b1 + layer * 64, freq);
  __syncthreads();
  mlp_layer(a1, 64, 64, a0, p.pe_w2 + layer * 64 * 64, p.pe_b2 + layer * 64, freq);
  __syncthreads();
  const int col0 = tid * 8, os = col0 >> 9, c0 = col0 & 511;
  const float* wout = p.pe_wout + (size_t)layer * 64 * 2048 + col0;
  u16* dstb = lat ? (u16*)(wsb + OFF_FL) + ((size_t)(layer * 4 + os) * 512 + c0) * 2048
                  : (u16*)(wsb + OFF_FC) + ((size_t)(layer * 4 + os) * 512 + c0) * 256;
  const float mind = -3.0701134573253946f, maxd = -15.350567286626973f;
#pragma unroll 1
  for (int g = 0; g < 8; ++g) {
    float acc[4][8];
#pragma unroll
    for (int a = 0; a < 4; ++a)
#pragma unroll
      for (int b = 0; b < 8; ++b) acc[a][b] = 0.f;
#pragma unroll 2
    for (int f = 0; f < 64; ++f) {
      float4 w0 = *(const float4*)(wout + (size_t)f * 2048), w1 = *(const float4*)(wout + (size_t)f * 2048 + 4);
      float wv[8] = {w0.x, w0.y, w0.z, w0.w, w1.x, w1.y, w1.z, w1.w};
#pragma unroll
      for (int lg = 0; lg < 4; ++lg) {
        float av = a0[(4 * g + lg) * 64 + f];
#pragma unroll
        for (int cc = 0; cc < 8; ++cc) acc[lg][cc] += av * wv[cc];
      }
    }
#pragma unroll
    for (int cc = 0; cc < 8; ++cc) {
      float delta = fabsf(mind + (maxd - mind) * ((float)(c0 + cc) / 511.f));
      float v[4];
#pragma unroll
      for (int lg = 0; lg < 4; ++lg) {
        float t = (float)(l0 + 4 * g + lg) / (float)(L - 1);
        v[lg] = acc[lg][cc] * __expf(-t * delta);
      }
      *(uint2*)(dstb + (size_t)cc * L + l0 + 4 * g) = make_uint2(pack2(v[0], v[1]), pack2(v[2], v[3]));
    }
  }
  __syncthreads();
}

DI void rope_item(const Params& p, char* wsb) {
  float* rt = (float*)(wsb + OFF_ROPE);
  for (int i = TIDX; i < 96 * 16; i += NTHR) {
    int pos = i >> 4, j = i & 15;
    float inv = 1.f / powf(10000.f, (float)(2 * j) / 32.f);
    if (pos < 32) { float a = (float)pos * inv; rt[pos * 16 + j] = cosf(a); rt[512 + pos * 16 + j] = sinf(a); }
    else { int cpos = pos - 32; float a = (float)cpos * inv; rt[1024 + cpos * 16 + j] = cosf(a); rt[2048 + cpos * 16 + j] = sinf(a); }
  }
  float* rb = (float*)(wsb + OFF_RPB);
  for (int i = TIDX; i < 4 * 8 * 15 * 160; i += NTHR) {
    int row = i / 160, e = i % 160;
    rb[i] = (e >= 64 && e < 95) ? p.na_rpb[row * 31 + e - 64] : 0.f;
  }
}

DI void phase_prep(const Params& p, char* wsb, char* lds) {
  const int nb = gridDim.x, bid = blockIdx.x, tid = TIDX;
  float4* xs = (float4*)(wsb + OFF_XS);
  const float4* xin = (const float4*)p.x;
  const float4* cin = (const float4*)p.ctx;
  const size_t nl = (size_t)TL * 256, nc = (size_t)TC * 256;
  {
    const size_t stride = (size_t)nb * NTHR;
#pragma unroll 8
    for (size_t i = (size_t)bid * NTHR + tid; i < nl; i += stride) { const f32x4v q = NT_LD4(xin + i); xs[i] = make_float4(q[0], q[1], q[2], q[3]); }
#pragma unroll 8
    for (size_t i = (size_t)bid * NTHR + tid; i < nc; i += stride) { const f32x4v q = NT_LD4(cin + i); xs[nl + i] = make_float4(q[0], q[1], q[2], q[3]); }
  }
  for (int it = bid; it < 577; it += nb) {
    if (it < 288) mods_partial(p, wsb, it, lds);
    else if (it < 576) filter_item(p, wsb, it - 288, lds);
    else rope_item(p, wsb);
  }
}

DI void phase_mods_reduce(const Params& p, char* wsb) {
  float* mods = (float*)(wsb + OFF_MODS);
  const float* mp = (const float*)(wsb + OFF_MODP);
  const int n = 4 * 9 * 9216;
  for (int i = blockIdx.x * NTHR + TIDX; i < n; i += gridDim.x * NTHR) {
    int layer = i / (9 * 9216), col = i % 9216;
    float s = p.b_ada[layer * 9216 + col];
#pragma unroll
    for (int k = 0; k < 8; ++k) s += mp[(size_t)k * n + i];
    mods[i] = s;
  }
}

DI void convert_tile(const float* __restrict__ src, int N, u16* __restrict__ dst, int K, int k0, int n0, int mode, float* t) {
  const int tid = TIDX;
#pragma unroll
  for (int i = 0; i < 4; ++i) {
    int q = tid + NTHR * i, kr = q >> 4, nc = (q & 15) * 4;
    const f32x4v v = NT_LD4(src + (size_t)(k0 + kr) * N + n0 + nc);
    t[kr * 65 + nc] = v[0]; t[kr * 65 + nc + 1] = v[1]; t[kr * 65 + nc + 2] = v[2]; t[kr * 65 + nc + 3] = v[3];
  }
  __syncthreads();
#pragma unroll
  for (int i = 0; i < 2; ++i) {
    int q = tid + NTHR * i, nr = q >> 3, kc = (q & 7) * 8;
    float v[8];
#pragma unroll
    for (int e = 0; e < 8; ++e) v[e] = t[(kc + e) * 65 + nr];
    int n = n0 + nr;
    int dn = mode == 0 ? n : (64 * (n >> 5) + (n & 31) + (mode == 2 ? 32 : 0));
    *(uint4*)(dst + (size_t)dn * K + k0 + kc) = make_uint4(pack2(v[0], v[1]), pack2(v[2], v[3]), pack2(v[4], v[5]), pack2(v[6], v[7]));
  }
  __syncthreads();
}

DI void convert_item(const Params& p, char* wsb, int layer, int it, char* lds) {
  u16* W = (u16*)(wsb + OFF_W);
  const float* src; u16* dst; int K, N, mode = 0, t = it;
  if (t < 4224) {
    int f = t / 2112; t %= 2112;
    int which = t / 704; t %= 704;
    size_t base = (size_t)(layer * 2 + f) * 1024 * 2816;
    if (which == 0) { src = p.ffn_wg + base; dst = W + (f ? W_GU1 : W_GU0); K = 1024; N = 2816; mode = 1; }
    else if (which == 1) { src = p.ffn_wu + base; dst = W + (f ? W_GU1 : W_GU0); K = 1024; N = 2816; mode = 2; }
    else { src = p.ffn_wd + base; dst = W + (f ? W_D1 : W_D0); K = 2816; N = 1024; }
  } else if (t < 4224 + 1728) {
    t -= 4224; src = p.w_in + (size_t)layer * 1024 * 6912; dst = W + W_IN; K = 1024; N = 6912;
  } else if (t < 4224 + 1728 + 384) {
    t -= 5952; int j = t / 128; t %= 128;
    src = p.w_branch + (size_t)(layer * 3 + j) * 512 * 1024; dst = W + W_B + (size_t)j * 1024 * 512; K = 512; N = 1024;
  } else {
    t -= 6336; src = p.w_out + (size_t)layer * 1024 * 1024; dst = W + W_O; K = 1024; N = 1024;
  }
  int ktiles = K >> 6;
  int kt = t % ktiles, nt = t / ktiles;
  convert_tile(src, N, dst, K, kt * 64, nt * 64, mode, (float*)lds);
}

DI void phase_norm(const Params& p, char* wsb, int layer, int which, int mrows, bool do_convert, char* lds) {
  const int tid = TIDX, lane = tid & 63, wid = tid >> 6;
  const float* xs = (const float*)(wsb + OFF_XS);
  u16* H = (u16*)(wsb + OFF_H);
  const float* mods = (const float*)(wsb + OFF_MODS) + (size_t)layer * 9 * 9216;
  const float* g = p.norm_g + (layer * 3 + which) * 1024;
  const int nw = gridDim.x * 4;
#pragma unroll 2
  for (int row = blockIdx.x * 4 + wid; row < mrows; row += nw) {
    const float4* xr = (const float4*)(xs + (size_t)row * 1024);
    float4 v[4];
    float ss = 0.f;
#pragma unroll
    for (int i = 0; i < 4; ++i) { v[i] = xr[lane + 64 * i]; ss += v[i].x * v[i].x + v[i].y * v[i].y + v[i].z * v[i].z + v[i].w * v[i].w; }
#pragma unroll
    for (int o = 32; o; o >>= 1) ss += __shfl_xor(ss, o);
    const float r = rsqrtf(ss * (1.f / 1024.f) + 1e-6f);
    const int mr = row < TL ? (row >> 11) : 8;
    const float* sh = mods + (size_t)mr * 9216 + (3 * which) * 1024;
    const float* sc = sh + 1024;
#pragma unroll
    for (int i = 0; i < 4; ++i) {
      int col = (lane + 64 * i) * 4;
      float4 gg = *(const float4*)(g + col), s4 = *(const float4*)(sh + col), c4 = *(const float4*)(sc + col);
      float o0 = v[i].x * r * gg.x * (1.f + c4.x) + s4.x;
      float o1 = v[i].y * r * gg.y * (1.f + c4.y) + s4.y;
      float o2 = v[i].z * r * gg.z * (1.f + c4.z) + s4.z;
      float o3 = v[i].w * r * gg.w * (1.f + c4.w) + s4.w;
      *(uint2*)(H + (size_t)row * 1024 + col) = make_uint2(pack2(o0, o1), pack2(o2, o3));
    }
  }
  if (do_convert) {
    for (int it = blockIdx.x; it < 6592; it += gridDim.x) convert_item(p, wsb, layer, it, lds);
  }
}

template <int AI, int BI>
DI void gemm_stage(const u16* __restrict__ A, int lda, const u16* __restrict__ B, int ldb, char* buf, int tid) {
#pragma unroll
  for (int i = 0; i < 2 * AI; ++i) {
    const int S = tid + NTHR * i, row = S >> 3, c = (S & 7) ^ ((row >> 1) & 7);
    __builtin_amdgcn_global_load_lds((const unsigned*)(A + (size_t)row * lda + c * 8), (__attribute__((address_space(3))) unsigned*)(buf + S * 16), 16, 0, 0);
  }
#pragma unroll
  for (int i = 0; i < 2 * BI; ++i) {
    const int S = tid + NTHR * i, row = S >> 3, c = (S & 7) ^ ((row >> 1) & 7);
    __builtin_amdgcn_global_load_lds((const unsigned*)(B + (size_t)row * ldb + c * 8), (__attribute__((address_space(3))) unsigned*)(buf + 16384 + S * 16), 16, 0, 0);
  }
}

template <int AI, int BI>
DI void gemm_tile(const u16* __restrict__ A, int lda, const u16* __restrict__ B, int ldb, int nk, bool swap,
                  f32x16 (&acc)[AI][BI], char* lds) {
  const int tid = TIDX, lane = tid & 63, wid = tid >> 6;
  gemm_stage<AI, BI>(A, lda, B, ldb, lds, tid);
  asm volatile("s_waitcnt vmcnt(0)" ::: "memory");
  __syncthreads();
  const int wa = wid >> 1, wb = wid & 1, r = lane & 31, h = lane >> 5, sw = (r >> 1) & 7;
  const int offA = (swap ? 16384 : 0) + (wa * 32 * AI + r) * 128;
  const int offB = (swap ? 0 : 16384) + (wb * 32 * BI + r) * 128;
  for (int kt = 0; kt < nk; ++kt) {
    const char* cur = lds + (kt & 1) * 32768;
    if (kt + 1 < nk) gemm_stage<AI, BI>(A + (kt + 1) * 64, lda, B + (kt + 1) * 64, ldb, lds + ((kt + 1) & 1) * 32768, tid);
#pragma unroll
    for (int ks = 0; ks < 4; ++ks) {
      const int co = ((ks * 2 + h) ^ sw) << 4;
      s16x8 fa[AI], fb[BI];
#pragma unroll
      for (int i = 0; i < AI; ++i) fa[i] = *(const s16x8*)(cur + offA + i * 4096 + co);
#pragma unroll
      for (int i = 0; i < BI; ++i) fb[i] = *(const s16x8*)(cur + offB + i * 4096 + co);
#pragma unroll
      for (int i = 0; i < AI; ++i)
#pragma unroll
        for (int j = 0; j < BI; ++j) acc[i][j] = MFMA(fa[i], fb[j], acc[i][j]);
    }
    asm volatile("s_waitcnt vmcnt(0)" ::: "memory");
    __syncthreads();
  }
}

template <int AI, int BI>
DI void zero_acc(f32x16 (&acc)[AI][BI]) {
#pragma unroll
  for (int a = 0; a < AI; ++a)
#pragma unroll
    for (int b = 0; b < BI; ++b)
#pragma unroll
      for (int i = 0; i < 16; ++i) acc[a][b][i] = 0.f;
}

DI void gemm_stage_w(const u16* __restrict__ A, int lda, const u16* __restrict__ B, int ldb, char* buf, int tid) {
#pragma unroll
  for (int i = 0; i < 2; ++i) {
    const int S = tid + NTHR * i, row = S >> 2, c = (S & 3) ^ ((row >> 2) & 3);
    __builtin_amdgcn_global_load_lds((const unsigned*)(A + (size_t)row * lda + c * 8), (__attribute__((address_space(3))) unsigned*)(buf + S * 16), 16, 0, 0);
  }
#pragma unroll
  for (int i = 0; i < 4; ++i) {
    const int S = tid + NTHR * i, row = S >> 2, c = (S & 3) ^ ((row >> 2) & 3);
    __builtin_amdgcn_global_load_lds((const unsigned*)(B + (size_t)row * ldb + c * 8), (__attribute__((address_space(3))) unsigned*)(buf + 8192 + S * 16), 16, 0, 0);
  }
}
DI void gemm_tile_w(const u16* __restrict__ A, int lda, const u16* __restrict__ B, int ldb, int nk, bool swap,
                    f32x16 (&acc)[2][4], char* lds) {
  const int tid = TIDX, lane = tid & 63, wid = tid >> 6;
  gemm_stage_w(A, lda, B, ldb, lds, tid);
  asm volatile("s_waitcnt vmcnt(0)" ::: "memory");
  __syncthreads();
  const int r = lane & 31, h = lane >> 5, sw = (r >> 2) & 3;
  const int wa = swap ? wid : (wid >> 1), wb = swap ? 0 : (wid & 1);
  const int offF = (swap ? 8192 : 0) + (wa * 64 + r) * 64;
  const int offS = (swap ? 0 : 8192) + (wb * 128 + r) * 64;
  for (int kt = 0; kt < nk; ++kt) {
    const char* cur = lds + (kt & 1) * 24576;
    if (kt + 1 < nk) gemm_stage_w(A + (kt + 1) * 32, lda, B + (kt + 1) * 32, ldb, lds + ((kt + 1) & 1) * 24576, tid);
#pragma unroll
    for (int ks = 0; ks < 2; ++ks) {
      const int co = ((ks * 2 + h) ^ sw) << 4;
      s16x8 f0 = *(const s16x8*)(cur + offF + co), f1 = *(const s16x8*)(cur + offF + 2048 + co);
#pragma unroll
      for (int si = 0; si < 4; ++si) {
        s16x8 sb = *(const s16x8*)(cur + offS + si * 2048 + co);
        acc[0][si] = MFMA(f0, sb, acc[0][si]);
        acc[1][si] = MFMA(f1, sb, acc[1][si]);
      }
    }
    asm volatile("s_waitcnt vmcnt(0)" ::: "memory");
    __syncthreads();
  }
}
DI void zero_acc_w(f32x16 (&acc)[2][4]) {
#pragma unroll
  for (int a = 0; a < 2; ++a)
#pragma unroll
    for (int b = 0; b < 4; ++b)
#pragma unroll
      for (int i = 0; i < 16; ++i) acc[a][b][i] = 0.f;
}

DI bool next_tile(int rnd, int MT, int NT, int& mt, int& nt) {
  const int G8 = gridDim.x >> 3, x = blockIdx.x & 7, slot = blockIdx.x >> 3;
  const int T = (rnd * 8 + x) * G8 + slot;
  if (T >= MT * NT) return false;
  const int band = T / (NT * 8), rem = T - band * NT * 8;
  nt = rem >> 3; mt = band * 8 + (rem & 7);
  return true;
}

template <int AI>
DI void gu_tile(char* wsb, int sub, int m0, int n0, char* lds) {
  const u16* H = (const u16*)(wsb + OFF_H);
  const u16* W = (const u16*)(wsb + OFF_W) + (sub ? W_GU1 : W_GU0);
  u16* HID = (u16*)(wsb + OFF_HID);
  const int lane = TIDX & 63, wid = TIDX >> 6, wa = wid >> 1, wb = wid & 1, r = lane & 31, h = lane >> 5;
  f32x16 acc[AI][2]; zero_acc<AI, 2>(acc);
  gemm_tile<AI, 2>(H + (size_t)m0 * 1024, 1024, W + (size_t)n0 * 1024, 1024, 16, false, acc, lds);
  const int m0e = m0 + opaque0();
  const int hc = (n0 >> 1) + wb * 32 + r;
  GAS u16* HIDu = uptr(HID);
  const unsigned ib = (unsigned)((m0e + wa * 32 * AI + 4 * h) * 2816 + hc);
#pragma unroll
  for (int ai = 0; ai < AI; ++ai)
#pragma unroll
    for (int reg = 0; reg < 16; ++reg) {
      float g = acc[ai][0][reg], u = acc[ai][1][reg];
      float v = g * __builtin_amdgcn_rcpf(1.f + __expf(-g)) * u;
      HIDu[ib + (unsigned)((ai * 32 + (reg & 3) + 8 * (reg >> 2)) * 2816)] = f2bf(v);
      if ((reg & 7) == 7) __builtin_amdgcn_sched_barrier(0);
    }
}
DI void phase_gu(const Params& p, char* wsb, int sub, int mrows, char* lds) {
  int mt, nt;
  for (int rnd = 0; next_tile(rnd, 128, 44, mt, nt); ++rnd) gu_tile<2>(wsb, sub, mt * 128, nt * 128, lds);
  if (mrows > TL)
    for (int rnd = 0; next_tile(rnd, 32, 44, mt, nt); ++rnd) gu_tile<1>(wsb, sub, TL + mt * 64, nt * 128, lds);
}

template <int AI, int BI>
DI void dn_tile(const Params& p, char* wsb, int layer, int sub, bool final_out, int m0, int n0, char* lds) {
  const u16* HID = (const u16*)(wsb + OFF_HID);
  const u16* W = (const u16*)(wsb + OFF_W) + (sub ? W_D1 : W_D0);
  float* xs = (float*)(wsb + OFF_XS);
  const float* mods = (const float*)(wsb + OFF_MODS) + (size_t)layer * 9 * 9216;
  const int lane = TIDX & 63, wid = TIDX >> 6, wa = wid >> 1, wb = wid & 1, r = lane & 31, h = lane >> 5;
  f32x16 acc[AI][BI]; zero_acc<AI, BI>(acc);
  gemm_tile<AI, BI>(HID + (size_t)m0 * 2816, 2816, W + (size_t)n0 * 2816, 2816, 44, false, acc, lds);
  const int m0e = m0 + opaque0();
  const int mr = m0 < TL ? (m0 >> 11) : 8;
  const float* gate = mods + (size_t)mr * 9216 + (2 + 6 * sub) * 1024;
  GAS float* xsu = uptr(xs);
  GAS float* outu = uptr(p.out);
#pragma unroll
  for (int bi = 0; bi < BI; ++bi) {
    const int n = n0 + wb * 32 * BI + bi * 32 + r;
    const float gv = 0.5f * gate[n];
    const unsigned ib = (unsigned)((m0e + wa * 32 * AI + 4 * h) * 1024 + n);
#pragma unroll
    for (int ai = 0; ai < AI; ++ai)
#pragma unroll
      for (int reg = 0; reg < 16; ++reg) {
        const unsigned idx = ib + (unsigned)((ai * 32 + (reg & 3) + 8 * (reg >> 2)) * 1024);
        float v = xsu[idx] + gv * acc[ai][bi][reg];
        if (final_out) outu[idx] = v; else xsu[idx] = v;
        if ((reg & 7) == 7) __builtin_amdgcn_sched_barrier(0);
      }
  }
}
DI void phase_dn(const Params& p, char* wsb, int layer, int sub, int mrows, bool final_out, char* lds) {
  int mt, nt;
  for (int rnd = 0; next_tile(rnd, 128, 8, mt, nt); ++rnd) dn_tile<2, 2>(p, wsb, layer, sub, final_out, mt * 128, nt * 128, lds);
  if (mrows > TL)
    for (int rnd = 0; next_tile(rnd, 32, 16, mt, nt); ++rnd) dn_tile<1, 1>(p, wsb, layer, sub, final_out, TL + mt * 64, nt * 64, lds);
}

DI void phase_in(const Params& p, char* wsb, int layer, char* lds) {
  const u16* H = (const u16*)(wsb + OFF_H);
  const u16* W = (const u16*)(wsb + OFF_W) + W_IN;
  const float* rope = (const float*)(wsb + OFF_ROPE);
  const int lane = TIDX & 63, wid = TIDX >> 6, wa = wid >> 1, wb = wid & 1, r = lane & 31, h = lane >> 5;
  int mt, nt;
  for (int rnd = 0; next_tile(rnd, 144, 54, mt, nt); ++rnd) {
    const int m0 = mt * 128, n0 = nt * 128;
    const bool swap = n0 < 3840;
    f32x16 acc[2][2]; zero_acc<2, 2>(acc);
    gemm_tile<2, 2>(H + (size_t)m0 * 1024, 1024, W + (size_t)n0 * 1024, 1024, 16, swap, acc, lds);
    const int m0e = m0 + opaque0();
    if (!swap) {
      GAS u16* G = uptr((u16*)(wsb + OFF_GATE));
#pragma unroll
      for (int bi = 0; bi < 2; ++bi) {
        const int n = n0 - 3840 + wb * 64 + bi * 32 + r;
        const unsigned ib = (unsigned)((m0e + wa * 64 + 4 * h) * 3072 + n);
#pragma unroll
        for (int ai = 0; ai < 2; ++ai)
#pragma unroll
          for (int reg = 0; reg < 16; ++reg)
            G[ib + (unsigned)((ai * 32 + (reg & 3) + 8 * (reg >> 2)) * 3072)] = f2bf(sigmoidf_(acc[ai][bi][reg]));
      }
      continue;
    }
    const bool isctx = m0 >= TL;
    if (n0 < 1536) {
#pragma unroll
      for (int bi = 0; bi < 2; ++bi) {
        const int m = m0e + wb * 64 + bi * 32 + r;
        u16* dst; size_t tstride;
        if (!isctx) { int b = m >> 11, t = m & 2047; dst = (u16*)(wsb + OFF_ZH) + (size_t)b * 1536 * 2048 + t; tstride = 2048; }
        else { int mm = m - TL; int b = mm >> 8, t = mm & 255; dst = (u16*)(wsb + OFF_ZHC) + (size_t)b * 1536 * 256 + t; tstride = 256; }
#pragma unroll
        for (int ai = 0; ai < 2; ++ai)
#pragma unroll
          for (int reg = 0; reg < 16; ++reg) {
            int n = n0 + wa * 64 + ai * 32 + crow(reg, h);
            dst[(size_t)n * tstride] = f2bf(acc[ai][bi][reg]);
          }
      }
      continue;
    }
    int kind, head;
    bool na;
    {
      int nn = n0 + wa * 64;
      if (nn < 2304) { na = false; int o = nn - 1536; if (o < 512) { kind = 0; head = o >> 6; } else if (o < 640) { kind = 1; head = (o - 512) >> 6; } else { kind = 2; head = (o - 640) >> 6; } }
      else { na = true; int o = nn - 2304; kind = o >> 9; head = (o & 511) >> 6; }
    }
    const int nheads = (!na && kind != 0) ? 2 : 8;
#pragma unroll
    for (int bi = 0; bi < 2; ++bi) {
      const int m = m0e + wb * 64 + bi * 32 + r;
      int b, tok, pos;
      if (!isctx) { b = m >> 11; pos = m & 2047; tok = pos; } else { int mm = m - TL; b = mm >> 8; pos = 0; tok = 2048 + (mm & 255); }
      if (kind == 2) {
        u16* dst = (u16*)(wsb + (na ? OFF_VTN : OFF_VTS)) + ((size_t)(b * nheads + head) * 64) * 2304 + tok;
#pragma unroll
        for (int ai = 0; ai < 2; ++ai)
#pragma unroll
          for (int reg = 0; reg < 16; ++reg) {
            int d = ai * 32 + crow(reg, h);
            dst[(size_t)d * 2304] = f2bf(acc[ai][bi][reg]);
          }
      } else {
        const float* gain = (na ? (kind == 0 ? p.na_qg : p.na_kg) : (kind == 0 ? p.swa_qg : p.swa_kg)) + layer * 64;
        float ss = 0.f;
#pragma unroll
        for (int ai = 0; ai < 2; ++ai)
#pragma unroll
          for (int reg = 0; reg < 16; ++reg) ss += acc[ai][bi][reg] * acc[ai][bi][reg];
        ss += __shfl_xor(ss, 32);
        const float rn = rsqrtf(ss * (1.f / 64.f) + 1e-6f);
        float v[2][16];
#pragma unroll
        for (int ai = 0; ai < 2; ++ai)
#pragma unroll
          for (int reg = 0; reg < 16; ++reg) v[ai][reg] = acc[ai][bi][reg] * rn * gain[ai * 32 + crow(reg, h)];
        if (!na && !isctx) {
          const int prow = pos >> 6, pcol = pos & 63;
#pragma unroll
          for (int ai = 0; ai < 2; ++ai) {
            const float* ct = ai == 0 ? rope + prow * 16 : rope + 1024 + pcol * 16;
            const float* st = ai == 0 ? rope + 512 + prow * 16 : rope + 2048 + pcol * 16;
#pragma unroll
            for (int reg = 0; reg < 8; ++reg) {
              int j = crow(reg, h);
              float cs = ct[j], sn = st[j];
              float x1 = v[ai][reg], x2 = v[ai][reg + 8];
              v[ai][reg] = x1 * cs - x2 * sn;
              v[ai][reg + 8] = x2 * cs + x1 * sn;
            }
          }
        }
        const float qs = kind == 0 ? 0.125f : 1.f;
        u16* dst = (u16*)(wsb + (na ? (kind == 0 ? OFF_QN : OFF_KN) : (kind == 0 ? OFF_QS : OFF_KS))) +
                   ((size_t)(b * nheads + head) * 2304 + tok) * 64;
#pragma unroll
        for (int ai = 0; ai < 2; ++ai)
#pragma unroll
          for (int g4 = 0; g4 < 4; ++g4) {
            int d0 = ai * 32 + 8 * g4 + 4 * h;
            *(uint2*)(dst + d0) = make_uint2(pack2(v[ai][4 * g4] * qs, v[ai][4 * g4 + 1] * qs), pack2(v[ai][4 * g4 + 2] * qs, v[ai][4 * g4 + 3] * qs));
          }
      }
    }
  }
}

template <int AI, int BI>
DI void m1_tile(char* wsb, int m0, int n0, char* lds) {
  const u16* Y = (const u16*)(wsb + OFF_Y);
  const u16* W = (const u16*)(wsb + OFF_W) + W_B;
  const u16* G = (const u16*)(wsb + OFF_GATE);
  u16* GM = (u16*)(wsb + OFF_H);
  const int tid = TIDX, lane = tid & 63, wid = tid >> 6, wa = wid >> 1, wb = wid & 1, r = lane & 31, h = lane >> 5, sw = (r >> 1) & 7;
  f32x16 tot[AI][BI], acc[AI][BI];
  zero_acc<AI, BI>(tot); zero_acc<AI, BI>(acc);
  const u16* Wt = W + (size_t)n0 * 512;
  const u16* Yt = Y + (size_t)m0 * 512;
  gemm_stage<AI, BI>(Wt, 512, Yt, 512, lds, tid);
  asm volatile("s_waitcnt vmcnt(0)" ::: "memory");
  __syncthreads();
  const int offA = (wa * 32 * AI + r) * 128;
  const int offB = 16384 + (wb * 32 * BI + r) * 128;
  uint2 gq[AI][BI][4];
#pragma unroll 1
  for (int kt = 0; kt < 24; ++kt) {
    const char* cur = lds + (kt & 1) * 32768;
    const int j = kt >> 3, kk = kt & 7;
    if (kt + 1 < 24) {
      const int j1 = (kt + 1) >> 3, k1 = (kt + 1) & 7;
      gemm_stage<AI, BI>(Wt + (size_t)j1 * 1024 * 512 + k1 * 64, 512, Yt + (size_t)j1 * TT * 512 + k1 * 64, 512, lds + ((kt + 1) & 1) * 32768, tid);
    }
    if (kk == 0) {
#pragma unroll
      for (int bi = 0; bi < BI; ++bi) {
        const size_t m = (size_t)(m0 + wb * 32 * BI + bi * 32 + r);
#pragma unroll
        for (int ai = 0; ai < AI; ++ai)
#pragma unroll
          for (int g4 = 0; g4 < 4; ++g4)
            gq[ai][bi][g4] = *(const uint2*)(G + m * 3072 + j * 1024 + n0 + wa * 32 * AI + ai * 32 + 8 * g4 + 4 * h);
      }
    }
#pragma unroll
    for (int ks = 0; ks < 4; ++ks) {
      const int co = ((ks * 2 + h) ^ sw) << 4;
      s16x8 fa[AI], fb[BI];
#pragma unroll
      for (int i = 0; i < AI; ++i) fa[i] = *(const s16x8*)(cur + offA + i * 4096 + co);
#pragma unroll
      for (int i = 0; i < BI; ++i) fb[i] = *(const s16x8*)(cur + offB + i * 4096 + co);
#pragma unroll
      for (int i = 0; i < AI; ++i)
#pragma unroll
        for (int jj = 0; jj < BI; ++jj) acc[i][jj] = MFMA(fa[i], fb[jj], acc[i][jj]);
    }
    if (kk == 7) {
#pragma unroll
      for (int ai = 0; ai < AI; ++ai)
#pragma unroll
        for (int bi = 0; bi < BI; ++bi)
#pragma unroll
          for (int g4 = 0; g4 < 4; ++g4) {
            const uint2 gv = gq[ai][bi][g4];
            tot[ai][bi][4 * g4 + 0] += bf2f((u16)(gv.x & 0xffff)) * acc[ai][bi][4 * g4 + 0];
            tot[ai][bi][4 * g4 + 1] += bf2f((u16)(gv.x >> 16)) * acc[ai][bi][4 * g4 + 1];
            tot[ai][bi][4 * g4 + 2] += bf2f((u16)(gv.y & 0xffff)) * acc[ai][bi][4 * g4 + 2];
            tot[ai][bi][4 * g4 + 3] += bf2f((u16)(gv.y >> 16)) * acc[ai][bi][4 * g4 + 3];
          }
      zero_acc<AI, BI>(acc);
    }
    asm volatile("s_waitcnt vmcnt(0)" ::: "memory");
    __syncthreads();
  }
  const int m0f = m0 + opaque0();
#pragma unroll
  for (int bi = 0; bi < BI; ++bi) {
    const size_t m = (size_t)(m0f + wb * 32 * BI + bi * 32 + r);
#pragma unroll
    for (int ai = 0; ai < AI; ++ai)
#pragma unroll
      for (int g4 = 0; g4 < 4; ++g4)
        *(uint2*)(GM + m * 1024 + n0 + wa * 32 * AI + ai * 32 + 8 * g4 + 4 * h) =
            make_uint2(pack2(tot[ai][bi][4 * g4], tot[ai][bi][4 * g4 + 1]), pack2(tot[ai][bi][4 * g4 + 2], tot[ai][bi][4 * g4 + 3]));
  }
}
DI void phase_m1(const Params& p, char* wsb, int mrows, char* lds) {
  int mt, nt;
  for (int rnd = 0; next_tile(rnd, 128, 8, mt, nt); ++rnd) m1_tile<2, 2>(wsb, mt * 128, nt * 128, lds);
  if (mrows > TL)
    for (int rnd = 0; next_tile(rnd, 32, 16, mt, nt); ++rnd) m1_tile<1, 1>(wsb, TL + mt * 64, nt * 64, lds);
}

template <int AI, int BI>
DI void m2_tile(char* wsb, int layer, int m0, int n0, char* lds) {
  const u16* GM = (const u16*)(wsb + OFF_H);
  const u16* W = (const u16*)(wsb + OFF_W) + W_O;
  float* xs = (float*)(wsb + OFF_XS);
  const float* mods = (const float*)(wsb + OFF_MODS) + (size_t)layer * 9 * 9216;
  const int lane = TIDX & 63, wid = TIDX >> 6, wa = wid >> 1, wb = wid & 1, r = lane & 31, h = lane >> 5;
  f32x16 acc[AI][BI]; zero_acc<AI, BI>(acc);
  gemm_tile<AI, BI>(GM + (size_t)m0 * 1024, 1024, W + (size_t)n0 * 1024, 1024, 16, false, acc, lds);
  const int m0e = m0 + opaque0();
  const int mr = m0 < TL ? (m0 >> 11) : 8;
  const float* gate = mods + (size_t)mr * 9216 + 5 * 1024;
  GAS float* xsu = uptr(xs);
#pragma unroll
  for (int bi = 0; bi < BI; ++bi) {
    const int n = n0 + wb * 32 * BI + bi * 32 + r;
    const float gv = gate[n];
    const unsigned ib = (unsigned)((m0e + wa * 32 * AI + 4 * h) * 1024 + n);
#pragma unroll
    for (int ai = 0; ai < AI; ++ai)
#pragma unroll
      for (int reg = 0; reg < 16; ++reg) {
        const unsigned idx = ib + (unsigned)((ai * 32 + (reg & 3) + 8 * (reg >> 2)) * 1024);
        xsu[idx] += gv * acc[ai][bi][reg];
        if ((reg & 7) == 7) __builtin_amdgcn_sched_barrier(0);
      }
  }
}
DI void phase_m2(const Params& p, char* wsb, int layer, int mrows, char* lds) {
  int mt, nt;
  for (int rnd = 0; next_tile(rnd, 128, 8, mt, nt); ++rnd) m2_tile<2, 2>(wsb, layer, mt * 128, nt * 128, lds);
  if (mrows > TL)
    for (int rnd = 0; next_tile(rnd, 32, 16, mt, nt); ++rnd) m2_tile<1, 1>(wsb, layer, TL + mt * 64, nt * 64, lds);
}

DI float sconv(const u16* z, int t, int L, float w0, float w1, float w2, float bb) {
  float zm = t > 0 ? bf2f(z[t - 1]) : 0.f, z0 = bf2f(z[t]), zp = t + 1 < L ? bf2f(z[t + 1]) : 0.f;
  return w0 * zm + w1 * z0 + w2 * zp + bb;
}

template <int NB1>
DI void hyena_item(const Params& p, char* wsb, int layer, int c, char* lds) {
  constexpr int L = NB1 * 32;
  constexpr int TPW = NB1 == 64 ? 4 : 1;
  const int tid = TIDX, lane = tid & 63, wid = tid >> 6, r = lane & 31, h = lane >> 5;
  u16* U = (u16*)lds;
  u16* R = (u16*)(lds + 40960);
  const u16* zbase = NB1 == 64 ? (const u16*)(wsb + OFF_ZH) : (const u16*)(wsb + OFF_ZHC);
  const float* sw = p.hy_short_w + layer * 3 * 1536;
  const float* sb = p.hy_short_b + layer * 1536;
  {
    const float w0 = sw[c], w1 = sw[1536 + c], w2 = sw[3072 + c], bb = sb[c];
#pragma unroll 2
    for (int ch = tid; ch < L; ch += NTHR) {
      const int b = ch / (L / 8), t = (ch % (L / 8)) * 8;
      const u16* zr = zbase + ((size_t)(b * 1536 + c)) * L;
      const uint4 zz = *(const uint4*)(zr + t);
      const float zm1 = bf2f(zr[t > 0 ? t - 1 : 0]) * (t > 0 ? 1.f : 0.f);
      const float zp8 = bf2f(zr[t + 8 < L ? t + 8 : L - 1]) * (t + 8 < L ? 1.f : 0.f);
      const unsigned zw[4] = {zz.x, zz.y, zz.z, zz.w};
      float zv[10];
      zv[0] = zm1; zv[9] = zp8;
#pragma unroll
      for (int q = 0; q < 4; ++q) { zv[1 + 2 * q] = bf2f((u16)(zw[q] & 0xffff)); zv[2 + 2 * q] = bf2f((u16)(zw[q] >> 16)); }
      float o[8];
#pragma unroll
      for (int e = 0; e < 8; ++e) o[e] = w0 * zv[e] + w1 * zv[e + 1] + w2 * zv[e + 2] + bb;
      *(uint4*)(U + (b * NB1 + (t >> 5)) * 40 + (t & 31)) = make_uint4(pack2(o[0], o[1]), pack2(o[2], o[3]), pack2(o[4], o[5]), pack2(o[6], o[7]));
    }
  }
  if (NB1 == 64) {
    unsigned acc_t = 0;
#pragma unroll
    for (int q = 0; q < 4; ++q) {
      const int b = 2 * wid + (q & 1), xc = (q >> 1 ? 1024 : 512) + c;
      const unsigned* rowp = (const unsigned*)(zbase + ((size_t)(b * 1536 + xc)) * L);
      acc_t += rowp[(lane & 31) * 32 + (lane >> 5) * 16];
    }
    asm volatile("" ::"v"(acc_t));
  }
  const bool active = NB1 == 64 ? true : (wid < 2);
  const u16* filt = NB1 == 64 ? (const u16*)(wsb + OFF_FL) : (const u16*)(wsb + OFF_FC);
  int tb[TPW], tt1[TPW];
#pragma unroll
  for (int j = 0; j < TPW; ++j) { int col = (wid * TPW + j) * 32 + r; tb[j] = col / NB1; tt1[j] = col % NB1; }
  int ub[TPW];
#pragma unroll
  for (int j = 0; j < TPW; ++j) ub[j] = ((tb[j] * NB1 + tt1[j]) * 40 + 8 * h) * 2;
  const int zaddr = 40960 + 2 * L * 2 + 64;
  const int pbase = (L - 1) - r + 8 * h;
  const unsigned sh = (unsigned)(pbase & 1) << 4;
  const unsigned* Rd = (const unsigned*)R + (pbase >> 1);
#pragma unroll 1
  for (int order = 0; order < 2; ++order) {
    __syncthreads();
    {
      const u16* fp = filt + ((size_t)((layer * 4 + order * 2 + 0) * 512 + c)) * L;
      const u16* fn = filt + ((size_t)((layer * 4 + order * 2 + 1) * 512 + c)) * L;
      for (int ch = tid; ch < (2 * L + 64) / 8; ch += NTHR) {
        const int i0 = ch * 8;
        uint4 o;
        if (i0 < L) {
          const uint4 v = *(const uint4*)(fp + (L - 8 - i0));
          o.x = (v.w >> 16) | (v.w << 16); o.y = (v.z >> 16) | (v.z << 16); o.z = (v.y >> 16) | (v.y << 16); o.w = (v.x >> 16) | (v.x << 16);
        } else {
          unsigned e8[8];
#pragma unroll
          for (int e = 0; e < 8; ++e) { const int i = i0 + e; e8[e] = i <= 2 * L - 2 ? (unsigned)fn[i - (L - 1)] : 0u; }
          o.x = e8[0] | (e8[1] << 16); o.y = e8[2] | (e8[3] << 16); o.z = e8[4] | (e8[5] << 16); o.w = e8[6] | (e8[7] << 16);
        }
        *(uint4*)(R + i0) = o;
      }
    }
    __syncthreads();
    if (active) {
      const int xcol = (order == 0 ? 512 : 1024) + c;
      const float w0 = sw[xcol], w1 = sw[1536 + xcol], w2 = sw[3072 + xcol], bb = sb[xcol];
      const float bias = p.hy_bias[(layer * 2 + order) * 512 + c];
      f32x16 acc[TPW];
#pragma unroll
      for (int j = 0; j < TPW; ++j)
#pragma unroll
        for (int i = 0; i < 16; ++i) acc[j][i] = 0.f;
      auto d1_range = [&](const int lo, const int hi, const int jmask) {
#pragma unroll 1
        for (int d1o = lo; d1o < hi; d1o += 2) {
#pragma unroll
          for (int dk = 0; dk < 4; ++dk) {
            const int d1 = d1o + (dk >> 1), ks = dk & 1;
            const unsigned* rp = Rd + (-16 * d1 + 8 * ks);
            unsigned w[5];
#pragma unroll
            for (int q = 0; q < 5; ++q) w[q] = rp[q];
            union { s16x8 v; unsigned u[4]; } af;
#pragma unroll
            for (int q = 0; q < 4; ++q) af.u[q] = __builtin_amdgcn_alignbit(w[q + 1], w[q], sh);
#pragma unroll
            for (int j = 0; j < TPW; ++j) {
              if (!((jmask >> (j & 1)) & 1)) continue;
              const bool ok = (unsigned)(tt1[j] - d1) < (unsigned)NB1;
              const int addr = ok ? ub[j] - d1 * 80 + ks * 32 : zaddr;
              const s16x8 bf = *(const s16x8*)(lds + addr);
              acc[j] = MFMA(af.v, bf, acc[j]);
            }
          }
        }
      };
      if (NB1 == 64) { d1_range(-64, -32, 1); d1_range(-32, 32, 3); d1_range(32, 64, 2); }
      else d1_range(-NB1, NB1, 3);
#pragma unroll
      for (int j = 0; j < TPW; ++j) {
        const u16* zr = zbase + ((size_t)(tb[j] * 1536 + xcol)) * L;
#pragma unroll
        for (int g4 = 0; g4 < 4; ++g4) {
          const int t0 = 8 * g4 + 4 * h, t = 32 * tt1[j] + t0;
          const int uidx = (tb[j] * NB1 + tt1[j]) * 40 + t0;
          const uint2 uu = *(const uint2*)(U + uidx);
          const uint2 zz = *(const uint2*)(zr + t);
          const float zm1 = t > 0 ? bf2f(zr[t - 1]) : 0.f;
          const float zp4 = t + 4 < L ? bf2f(zr[t + 4]) : 0.f;
          const float zv[6] = {zm1, bf2f((u16)(zz.x & 0xffff)), bf2f((u16)(zz.x >> 16)), bf2f((u16)(zz.y & 0xffff)), bf2f((u16)(zz.y >> 16)), zp4};
          const float uv[4] = {bf2f((u16)(uu.x & 0xffff)), bf2f((u16)(uu.x >> 16)), bf2f((u16)(uu.y & 0xffff)), bf2f((u16)(uu.y >> 16))};
          float yv[4];
#pragma unroll
          for (int e = 0; e < 4; ++e) {
            const float xv = w0 * zv[e] + w1 * zv[e + 1] + w2 * zv[e + 2] + bb;
            yv[e] = xv * (acc[j][4 * g4 + e] + bias * uv[e]);
          }
          if (order == 0) *(uint2*)(U + uidx) = make_uint2(pack2(yv[0], yv[1]), pack2(yv[2], yv[3]));
          else {
            const size_t row = NB1 == 64 ? (size_t)tb[j] * 2048 + t : (size_t)TL + tb[j] * 256 + t;
            u16* yo = (u16*)(wsb + OFF_Y) + row * 512 + c;
#pragma unroll
            for (int e = 0; e < 4; ++e) yo[(size_t)e * 512] = f2bf(yv[e]);
          }
        }
      }
    }
  }
}

template <int MODE>
DI void attn_wave(const u16* __restrict__ Q, const u16* __restrict__ K, const u16* __restrict__ Vt, u16* __restrict__ Yout,
                  int qpos0, const float* rpb, float sink, bool has_sink) {
  const int lane = TIDX & 63, r = lane & 31, h = lane >> 5;
  s16x8 qf[4];
#pragma unroll
  for (int ks = 0; ks < 4; ++ks) qf[ks] = *(const s16x8*)(Q + r * 64 + ks * 16 + h * 8);
  f32x16 O0, O1;
#pragma unroll
  for (int i = 0; i < 16; ++i) { O0[i] = 0.f; O1[i] = 0.f; }
  float mrun = -INFINITY, lrun = 0.f;
  int nloc = 0, jlo = 0, qr = 0, qc = 0, rs = 0;
  if (MODE == 0) {
    jlo = qpos0 < 128 ? (128 - qpos0) >> 5 : 0;
    const int jhi = min(8, (2047 - (qpos0 - 128)) >> 5);
    nloc = jhi - jlo + 1;
  } else if (MODE == 1) {
    qr = qpos0 >> 6; qc = (qpos0 & 63) + r; rs = min(max(qr - 4, 0), 24); nloc = 16;
  }
  const int ntiles = 8 + nloc;
  auto tile_kb = [&](int i) -> int {
    if (i < 8) return 2048 + i * 32;
    const int j = i - 8;
    if (MODE == 0) return qpos0 - 128 + 32 * (jlo + j);
    return (rs + (j >> 1)) * 64 + 32 * (j & 1);
  };
  const u16* kbase = K + (size_t)r * 64 + h * 8;
  const u16* vbase = Vt + (size_t)r * 2304 + 4 * h;
  s16x8 kf[4];
  {
    const int kb = tile_kb(0);
#pragma unroll
    for (int ks = 0; ks < 4; ++ks) kf[ks] = *(const s16x8*)(kbase + (size_t)kb * 64 + ks * 16);
  }
#pragma unroll 1
  for (int i = 0; i < ntiles; ++i) {
    const int kb = tile_kb(i);
    union { s16x8 v; uint2 u[2]; } v0[2], v1[2];
#pragma unroll
    for (int s2 = 0; s2 < 2; ++s2) {
      const u16* vp0 = vbase + kb + 16 * s2;
      const u16* vp1 = vp0 + (size_t)32 * 2304;
      v0[s2].u[0] = *(const uint2*)vp0; v0[s2].u[1] = *(const uint2*)(vp0 + 8);
      v1[s2].u[0] = *(const uint2*)vp1; v1[s2].u[1] = *(const uint2*)(vp1 + 8);
    }
    s16x8 kn[4];
    {
      const int kbn = tile_kb(i + 1 < ntiles ? i + 1 : i);
#pragma unroll
      for (int ks = 0; ks < 4; ++ks) kn[ks] = *(const s16x8*)(kbase + (size_t)kbn * 64 + ks * 16);
    }
    f32x16 S;
#pragma unroll
    for (int q = 0; q < 16; ++q) S[q] = 0.f;
#pragma unroll
    for (int ks = 0; ks < 4; ++ks) S = MFMA(kf[ks], qf[ks], S);
    if (i >= 8) {
      if (MODE == 0) {
        const int d0 = (qpos0 + r) - (kb + 4 * h);
#pragma unroll
        for (int reg = 0; reg < 16; ++reg) { const int d = d0 - ((reg & 3) + 8 * (reg >> 2)); if (d > 128 || d < -128) S[reg] = -INFINITY; }
      } else if (MODE == 1) {
        const int j = i - 8;
        const float* brow = rpb + ((rs + (j >> 1)) - qr + 7) * 160 + 64;
        const int cstart = min(max(qc - 8, 0), 48);
        const int kc0 = 32 * (j & 1) + 4 * h;
        const float* bp = brow + (kc0 - qc + 15);
        const int rel = kc0 - cstart;
#pragma unroll
        for (int reg = 0; reg < 16; ++reg) {
          const int o = (reg & 3) + 8 * (reg >> 2);
          const bool ok = (unsigned)(rel + o) < 16u;
          S[reg] = ok ? S[reg] + bp[o] : -INFINITY;
        }
      }
    }
    float mx = S[0];
#pragma unroll
    for (int reg = 1; reg < 16; ++reg) mx = fmaxf(mx, S[reg]);
    mx = fmaxf(mx, __shfl_xor(mx, 32));
    const float mnew = fmaxf(mrun, mx);
    const float alpha = __expf(mrun - mnew);
    float ps = 0.f;
#pragma unroll
    for (int reg = 0; reg < 16; ++reg) { S[reg] = __expf(S[reg] - mnew); ps += S[reg]; }
    lrun = lrun * alpha + ps;
    mrun = mnew;
#pragma unroll
    for (int q = 0; q < 16; ++q) { O0[q] *= alpha; O1[q] *= alpha; }
#pragma unroll
    for (int s2 = 0; s2 < 2; ++s2) {
      union { s16x8 v; unsigned u[4]; } pf;
#pragma unroll
      for (int q = 0; q < 4; ++q) pf.u[q] = pack2(S[8 * s2 + 2 * q], S[8 * s2 + 2 * q + 1]);
      O0 = MFMA(v0[s2].v, pf.v, O0);
      O1 = MFMA(v1[s2].v, pf.v, O1);
    }
#pragma unroll
    for (int ks = 0; ks < 4; ++ks) kf[ks] = kn[ks];
  }
  float lt = lrun + __shfl_xor(lrun, 32);
  if (has_sink) lt += __expf(sink - mrun);
  const float inv = 1.f / lt;
  u16* yo = Yout + (size_t)r * 512;
#pragma unroll
  for (int g4 = 0; g4 < 4; ++g4) {
    *(uint2*)(yo + 8 * g4 + 4 * h) = make_uint2(pack2(O0[4 * g4] * inv, O0[4 * g4 + 1] * inv), pack2(O0[4 * g4 + 2] * inv, O0[4 * g4 + 3] * inv));
    *(uint2*)(yo + 32 + 8 * g4 + 4 * h) = make_uint2(pack2(O1[4 * g4] * inv, O1[4 * g4 + 1] * inv), pack2(O1[4 * g4 + 2] * inv, O1[4 * g4 + 3] * inv));
  }
}

constexpr int AT_BUF = 8192 + 64 * 136;
DI void attn_stage_k(const u16* __restrict__ K, int kb, char* buf, int tid) {
#pragma unroll
  for (int i = 0; i < 2; ++i) {
    const int S = tid + NTHR * i, row = S >> 3, c = (S & 7) ^ ((row >> 1) & 7);
    __builtin_amdgcn_global_load_lds((const unsigned*)(K + (size_t)(kb + row) * 64 + c * 8), (__attribute__((address_space(3))) unsigned*)(buf + S * 16), 16, 0, 0);
  }
}
template <int MODE>
DI void attn_block(const u16* __restrict__ Q, const u16* __restrict__ K, const u16* __restrict__ Vt, u16* __restrict__ Yout,
                   int qpos0, int blk_lo, int blk_n, int w_lo, const float* rpb, float sink, bool has_sink, char* lds) {
  const int tid = TIDX, lane = tid & 63, r = lane & 31, h = lane >> 5;
  s16x8 qf[4];
#pragma unroll
  for (int ks = 0; ks < 4; ++ks) qf[ks] = *(const s16x8*)(Q + r * 64 + ks * 16 + h * 8);
  f32x16 O0, O1;
#pragma unroll
  for (int i = 0; i < 16; ++i) { O0[i] = 0.f; O1[i] = 0.f; }
  float mrun = -INFINITY, lrun = 0.f;
  const int nloc = MODE == 0 ? (blk_n + 1) >> 1 : (MODE == 1 ? blk_n : 0);
  const int nst = 4 + nloc;
  auto step_kb = [&](int st) -> int {
    if (st < 4) return 2048 + st * 64;
    return MODE == 0 ? blk_lo + 64 * (st - 4) : (blk_lo + (st - 4)) * 64;
  };
  typedef __attribute__((ext_vector_type(4))) unsigned u32x4;
  const int vd = tid >> 3, vc = (tid & 7) * 8;
  const int kwofs = vd * 128 + (((tid & 7) ^ ((vd >> 1) & 7)) << 4);
  u32x4 kp[2], vp[2], kq[2], vq[2];
  const int sw = (r >> 1) & 7;
  const int qr = qpos0 >> 6, qc = (qpos0 & 63) + r;
#define AT_LOAD(KR, VR, ST) do { const int kb_ = step_kb((ST) < nst ? (ST) : nst - 1); \
    _Pragma("unroll") for (int i = 0; i < 2; ++i) { KR[i] = *(const u32x4*)(K + (size_t)(kb_ + vd + 32 * i) * 64 + vc); \
                                                    VR[i] = *(const u32x4*)(Vt + (size_t)(vd + 32 * i) * 2304 + kb_ + vc); } } while (0)
#define AT_STORE(KR, VR, BUF) do { _Pragma("unroll") for (int i = 0; i < 2; ++i) { *(u32x4*)((BUF) + kwofs + i * 4096) = KR[i]; \
    char* vp_ = (BUF) + 8192 + (vd + 32 * i) * 136 + vc * 2; \
    *(uint2*)vp_ = make_uint2(VR[i][0], VR[i][1]); *(uint2*)(vp_ + 8) = make_uint2(VR[i][2], VR[i][3]); } } while (0)
  auto compute = [&](const int st, const char* cur) {
    const int kb = step_kb(st);
    bool wave_on = true;
    if (MODE == 1 && st >= 4) { const int rr = blk_lo + (st - 4); wave_on = rr >= w_lo && rr < w_lo + 8; }
    if (wave_on) {
#pragma unroll
      for (int th = 0; th < 2; ++th) {
        if (MODE == 0 && st >= 4 && 2 * (st - 4) + th >= blk_n) continue;
        f32x16 S;
#pragma unroll
        for (int q = 0; q < 16; ++q) S[q] = 0.f;
#pragma unroll
        for (int ks = 0; ks < 4; ++ks) {
          const s16x8 kf = *(const s16x8*)(cur + (th * 32 + r) * 128 + (((ks * 2 + h) ^ sw) << 4));
          S = MFMA(kf, qf[ks], S);
        }
        if (st >= 4) {
          if (MODE == 0) {
            const int d0 = (qpos0 + r) - (kb + 32 * th + 4 * h);
#pragma unroll
            for (int reg = 0; reg < 16; ++reg) { const int d = d0 - ((reg & 3) + 8 * (reg >> 2)); if (d > 128 || d < -128) S[reg] = -INFINITY; }
          } else if (MODE == 1) {
            const int rr = blk_lo + (st - 4);
            const float* brow = rpb + (rr - qr + 7) * 160 + 64;
            const int cstart = min(max(qc - 8, 0), 48);
            const int kc0 = 32 * th + 4 * h;
            const float* bp = brow + (kc0 - qc + 15);
            const int rel = kc0 - cstart;
#pragma unroll
            for (int reg = 0; reg < 16; ++reg) {
              const int o = (reg & 3) + 8 * (reg >> 2);
              const bool ok = (unsigned)(rel + o) < 16u;
              const float tb = S[reg] + bp[o];
              S[reg] = ok ? tb : -INFINITY;
            }
          }
        }
        float mx = S[0];
#pragma unroll
        for (int reg = 1; reg < 16; ++reg) mx = fmaxf(mx, S[reg]);
        mx = fmaxf(mx, __shfl_xor(mx, 32));
        const float mnew = fmaxf(mrun, mx);
        const float alpha = __expf(mrun - mnew);
        float ps = 0.f;
#pragma unroll
        for (int reg = 0; reg < 16; ++reg) { S[reg] = __expf(S[reg] - mnew); ps += S[reg]; }
        lrun = lrun * alpha + ps;
        mrun = mnew;
#pragma unroll
        for (int q = 0; q < 16; ++q) { O0[q] *= alpha; O1[q] *= alpha; }
#pragma unroll
        for (int s2 = 0; s2 < 2; ++s2) {
          union { s16x8 v; unsigned u[4]; } pf;
#pragma unroll
          for (int q = 0; q < 4; ++q) pf.u[q] = pack2(S[8 * s2 + 2 * q], S[8 * s2 + 2 * q + 1]);
          union { s16x8 v; uint2 u[2]; } v0, v1;
          const char* vp0 = cur + 8192 + r * 136 + (32 * th + 16 * s2 + 4 * h) * 2;
          const char* vp1 = vp0 + 32 * 136;
          v0.u[0] = *(const uint2*)vp0; v0.u[1] = *(const uint2*)(vp0 + 16);
          v1.u[0] = *(const uint2*)vp1; v1.u[1] = *(const uint2*)(vp1 + 16);
          O0 = MFMA(v0.v, pf.v, O0);
          O1 = MFMA(v1.v, pf.v, O1);
        }
      }
    }
  };
  char* buf0 = lds;
  char* buf1 = lds + AT_BUF;
  AT_LOAD(kp, vp, 0);
  AT_STORE(kp, vp, buf0);
  AT_LOAD(kp, vp, 1);
  __syncthreads();
#pragma unroll 1
  for (int st = 0; st < nst; st += 2) {
    AT_LOAD(kq, vq, st + 2);
    __builtin_amdgcn_sched_barrier(0);
    compute(st, buf0);
    AT_STORE(kp, vp, buf1);
    __syncthreads();
    if (st + 1 < nst) {
      AT_LOAD(kp, vp, st + 3);
      __builtin_amdgcn_sched_barrier(0);
      compute(st + 1, buf1);
      AT_STORE(kq, vq, buf0);
      __syncthreads();
    }
  }
#undef AT_LOAD
#undef AT_STORE
  float lt = lrun + __shfl_xor(lrun, 32);
  if (has_sink) lt += __expf(sink - mrun);
  const float inv = 1.f / lt;
  u16* yo = Yout + (size_t)r * 512;
#pragma unroll
  for (int g4 = 0; g4 < 4; ++g4) {
    *(uint2*)(yo + 8 * g4 + 4 * h) = make_uint2(pack2(O0[4 * g4] * inv, O0[4 * g4 + 1] * inv), pack2(O0[4 * g4 + 2] * inv, O0[4 * g4 + 3] * inv));
    *(uint2*)(yo + 32 + 8 * g4 + 4 * h) = make_uint2(pack2(O1[4 * g4] * inv, O1[4 * g4 + 1] * inv), pack2(O1[4 * g4 + 2] * inv, O1[4 * g4 + 3] * inv));
  }
}

DI void phase_mix(const Params& p, char* wsb, int layer, char* lds) {
  const bool upd = layer < 3;
  const int n_hl = 512, n_swa = 1024, n_na = 1024, n_ca = upd ? 256 : 0, n_hc = upd ? 512 : 0;
  const int total = n_hl + n_swa + n_na + n_ca + n_hc;
  const int wid = TIDX >> 6;
  u16* Y = (u16*)(wsb + OFF_Y);
  const u16* QS = (const u16*)(wsb + OFF_QS);
  const u16* KS = (const u16*)(wsb + OFF_KS);
  const u16* VTS = (const u16*)(wsb + OFF_VTS);
  const u16* QN = (const u16*)(wsb + OFF_QN);
  const u16* KN = (const u16*)(wsb + OFF_KN);
  const u16* VTN = (const u16*)(wsb + OFF_VTN);
  const int nmine = (total - (int)blockIdx.x + (int)gridDim.x - 1) / (int)gridDim.x;
  const bool rev = blockIdx.x >= (gridDim.x >> 1);
#pragma unroll 1
  for (int q = 0; q < nmine; ++q) {
    const int it = (int)blockIdx.x + (rev ? nmine - 1 - q : q) * (int)gridDim.x;
    int t = it;
    __syncthreads();
    if (t < n_hl) { const int ch = (t & 7) * 64 + (t >> 3); REP(9) { __syncthreads(); hyena_item<64>(p, wsb, layer, ch, lds); } continue; }
    t -= n_hl;
    if (t < n_swa) { REP(10) {
      const int b = t >> 7, kvh = (t >> 6) & 1, qt = t & 63, head = kvh * 4 + wid;
      const int q0 = qt * 32;
      const int lo = max(q0 - 128, 0), hi = min(q0 + 128, 2016);
      __syncthreads();
      if (!(ATT_NEW & 1)) attn_wave<0>(QS + ((size_t)(b * 8 + head) * 2304 + q0) * 64, KS + (size_t)(b * 2 + kvh) * 2304 * 64, VTS + (size_t)(b * 2 + kvh) * 64 * 2304,
                   Y + ((size_t)1 * TT + (size_t)b * 2048 + q0) * 512 + head * 64, q0, nullptr, p.swa_sink[layer * 8 + head], true);
      else attn_block<0>(QS + ((size_t)(b * 8 + head) * 2304 + q0) * 64, KS + (size_t)(b * 2 + kvh) * 2304 * 64, VTS + (size_t)(b * 2 + kvh) * 64 * 2304,
                    Y + ((size_t)1 * TT + (size_t)b * 2048 + q0) * 512 + head * 64, q0, lo, ((hi - lo) >> 5) + 1, 0, nullptr, p.swa_sink[layer * 8 + head], true, lds); }
      continue;
    }
    t -= n_swa;
    if (t < n_na) { REP(10) {
      const int b = t >> 7, head = (t >> 4) & 7, rp = t & 15;
      const int row = rp * 2 + (wid >> 1);
      const int q0 = row * 64 + (wid & 1) * 32;
      const int rs0 = min(max(2 * rp - 4, 0), 24), rs1 = min(max(2 * rp + 1 - 4, 0), 24);
      __syncthreads();
      if (!(ATT_NEW & 2)) attn_wave<1>(QN + ((size_t)(b * 8 + head) * 2304 + q0) * 64, KN + (size_t)(b * 8 + head) * 2304 * 64, VTN + (size_t)(b * 8 + head) * 64 * 2304,
                   Y + ((size_t)2 * TT + (size_t)b * 2048 + q0) * 512 + head * 64, q0, (const float*)(wsb + OFF_RPB) + (size_t)(layer * 8 + head) * 15 * 160, 0.f, false);
      else attn_block<1>(QN + ((size_t)(b * 8 + head) * 2304 + q0) * 64, KN + (size_t)(b * 8 + head) * 2304 * 64, VTN + (size_t)(b * 8 + head) * 64 * 2304,
                    Y + ((size_t)2 * TT + (size_t)b * 2048 + q0) * 512 + head * 64, q0, rs0, rs1 - rs0 + 8, min(max(row - 4, 0), 24),
                    (const float*)(wsb + OFF_RPB) + (size_t)(layer * 8 + head) * 15 * 160, 0.f, false, lds); }
      continue;
    }
    t -= n_na;
    if (t < n_ca) {
      const int b = t >> 5, h16 = (t >> 1) & 15, qt = (t & 1) * 4 + wid;
      const int q0 = 2048 + qt * 32;
      if (h16 < 8) {
        const int head = h16, kvh = head >> 2;
        if (!(ATT_NEW & 4)) attn_wave<2>(QS + ((size_t)(b * 8 + head) * 2304 + q0) * 64, KS + (size_t)(b * 2 + kvh) * 2304 * 64, VTS + (size_t)(b * 2 + kvh) * 64 * 2304,
                     Y + ((size_t)1 * TT + (size_t)TL + b * 256 + qt * 32) * 512 + head * 64, 0, nullptr, p.swa_sink[layer * 8 + head], true);
        else attn_block<2>(QS + ((size_t)(b * 8 + head) * 2304 + q0) * 64, KS + (size_t)(b * 2 + kvh) * 2304 * 64, VTS + (size_t)(b * 2 + kvh) * 64 * 2304,
                      Y + ((size_t)1 * TT + (size_t)TL + b * 256 + qt * 32) * 512 + head * 64, 0, 0, 0, 0, nullptr, p.swa_sink[layer * 8 + head], true, lds);
      } else {
        const int head = h16 - 8;
        if (!(ATT_NEW & 4)) attn_wave<2>(QN + ((size_t)(b * 8 + head) * 2304 + q0) * 64, KN + (size_t)(b * 8 + head) * 2304 * 64, VTN + (size_t)(b * 8 + head) * 64 * 2304,
                     Y + ((size_t)2 * TT + (size_t)TL + b * 256 + qt * 32) * 512 + head * 64, 0, nullptr, 0.f, false);
        else attn_block<2>(QN + ((size_t)(b * 8 + head) * 2304 + q0) * 64, KN + (size_t)(b * 8 + head) * 2304 * 64, VTN + (size_t)(b * 8 + head) * 64 * 2304,
                      Y + ((size_t)2 * TT + (size_t)TL + b * 256 + qt * 32) * 512 + head * 64, 0, 0, 0, 0, nullptr, 0.f, false, lds);
      }
      continue;
    }
    t -= n_ca;
    hyena_item<8>(p, wsb, layer, (t & 7) * 64 + (t >> 3), lds);
  }
}

__global__ void __launch_bounds__(NTHR, 2) fwd_megakernel(Params p0) {
  __shared__ __attribute__((aligned(16))) char lds[65536];
  cg::grid_group grid = cg::this_grid();
  __shared__ uint4 xb_words;
  if (threadIdx.x == 0) xb_words = make_uint4(0u, 0u, 0u, 0u);
  __syncthreads();
  const XcdBarrier xb = xcd_barrier_post((unsigned*)(p0.ws + OFF_BAR), (volatile LAS unsigned*)&xb_words);
  REP(8) { unsigned zo = 0; asm volatile("" : "+s"(zo)); char* wsl = p0.ws + zo; phase_prep(p0, wsl, lds); }
  if (p0.out == nullptr) grid.sync();
  xcd_barrier(xb);
  { unsigned zo = 0; asm volatile("" : "+s"(zo)); char* wsl = p0.ws + zo; phase_mods_reduce(p0, wsl); }
  xcd_barrier(xb);
  for (int layer = 0; layer < 4; ++layer) {
    const bool last = layer == 3;
    const int mr2 = last ? TL : TT;
    REP(4) { unsigned zo = 0; asm volatile("" : "+s"(zo)); char* wsl = p0.ws + zo; phase_norm(p0, wsl, layer, 0, TT, true, lds); }
    REP(5) xcd_barrier(xb);
    REP(1) { unsigned zo = 0; asm volatile("" : "+s"(zo)); char* wsl = p0.ws + zo; phase_gu(p0, wsl, 0, TT, lds); }
    REP(5) xcd_barrier(xb);
    { unsigned zo = 0; asm volatile("" : "+s"(zo)); char* wsl = p0.ws + zo; phase_dn(p0, wsl, layer, 0, TT, false, lds); }
    REP(5) xcd_barrier(xb);
    REP(4) { unsigned zo = 0; asm volatile("" : "+s"(zo)); char* wsl = p0.ws + zo; phase_norm(p0, wsl, layer, 1, TT, false, lds); }
    REP(5) xcd_barrier(xb);
    REP(2) { unsigned zo = 0; asm volatile("" : "+s"(zo)); char* wsl = p0.ws + zo; phase_in(p0, wsl, layer, lds); }
    REP(5) xcd_barrier(xb);
    REP(3) { unsigned zo = 0; asm volatile("" : "+s"(zo)); char* wsl = p0.ws + zo; phase_mix(p0, wsl, layer, lds); }
    REP(5) xcd_barrier(xb);
    REP(7) { unsigned zo = 0; asm volatile("" : "+s"(zo)); char* wsl = p0.ws + zo; phase_m1(p0, wsl, mr2, lds); }
    REP(5) xcd_barrier(xb);
    { unsigned zo = 0; asm volatile("" : "+s"(zo)); char* wsl = p0.ws + zo; phase_m2(p0, wsl, layer, mr2, lds); }
    REP(5) xcd_barrier(xb);
    REP(4) { unsigned zo = 0; asm volatile("" : "+s"(zo)); char* wsl = p0.ws + zo; phase_norm(p0, wsl, layer, 2, mr2, false, lds); }
    REP(5) xcd_barrier(xb);
    REP(1) { unsigned zo = 0; asm volatile("" : "+s"(zo)); char* wsl = p0.ws + zo; phase_gu(p0, wsl, 1, mr2, lds); }
    REP(5) xcd_barrier(xb);
    { unsigned zo = 0; asm volatile("" : "+s"(zo)); char* wsl = p0.ws + zo; phase_dn(p0, wsl, layer, 1, mr2, last, lds); }
    if (!last) { REP(5) xcd_barrier(xb); }
  }
}

extern "C" void kernel_launch(void* const* d_in, const int* in_sizes, int n_in, void* d_out, int out_size, void* d_ws,
                              size_t ws_size, hipStream_t stream) {
  static int grid_blocks = 0;
  if (!grid_blocks) {
    int dev = 0, cus = 0, per_cu = 0;
    hipGetDevice(&dev);
    hipDeviceGetAttribute(&cus, hipDeviceAttributeMultiprocessorCount, dev);
    hipOccupancyMaxActiveBlocksPerMultiprocessor(&per_cu, fwd_megakernel, NTHR, 0);
    if (per_cu > 2) per_cu = 2;
    if (per_cu < 1) per_cu = 1;
    grid_blocks = (cus * per_cu) & ~7;
  }
  if (ws_size < WS_NEED) { fprintf(stderr, "workspace too small: %zu < %zu\n", ws_size, WS_NEED); return; }
  Params p{};
  const float** f = (const float**)&p;
  for (int i = 0; i < 30; ++i) f[i] = (const float*)d_in[i];
  p.out = (float*)d_out;
  p.ws = (char*)d_ws;
  hipMemsetAsync(d_ws, 0, 16384, stream);
  void* args[] = {&p};
  hipError_t e = hipLaunchCooperativeKernel((void*)fwd_megakernel, dim3(grid_blocks), dim3(NTHR), args, 0, stream);
  if (e != hipSuccess) fprintf(stderr, "cooperative launch failed: %s (grid %d)\n", hipGetErrorString(e), grid_blocks);
}
```

```cpp
#include <hip/hip_runtime.h>
#include <hip/hip_cooperative_groups.h>
#include <cstdio>
namespace cg = cooperative_groups;

typedef unsigned short u16;
typedef __attribute__((ext_vector_type(8))) short s16x8;
typedef __attribute__((ext_vector_type(16))) float f32x16;
#define DI __device__ __forceinline__
typedef float f32x4v __attribute__((ext_vector_type(4)));
#define NT_LD4(ptr) __builtin_nontemporal_load((const f32x4v*)(ptr))
#define MFMA(a, b, c) __builtin_amdgcn_mfma_f32_32x32x16_bf16((a), (b), (c), 0, 0, 0)

constexpr int TL = 16384, TC = 2048, TT = 18432;
constexpr int NTHR = 256;
#ifndef PROBE
#define PROBE 0
#endif
#ifndef ATT_NEW
#define ATT_NEW 3
#endif
#define REP(k) for (int rep_ = 0; rep_ < (PROBE == (k) ? 2 : 1); ++rep_)

constexpr size_t OFF_BAR  = 0;
constexpr size_t OFF_MODS = 16384;
constexpr size_t SZ_MODS  = (size_t)4 * 9 * 9216 * 4;
constexpr size_t OFF_MODP = OFF_MODS + SZ_MODS;
constexpr size_t OFF_ROPE = OFF_MODP + 8 * SZ_MODS;
constexpr size_t OFF_RPB  = OFF_ROPE + 16384;
constexpr size_t OFF_FL   = OFF_RPB + 307200;
constexpr size_t OFF_FC   = OFF_FL + (size_t)4 * 4 * 512 * 2048 * 2;
constexpr size_t OFF_XS   = OFF_FC + (size_t)4 * 4 * 512 * 256 * 2;
constexpr size_t OFF_H    = OFF_XS + (size_t)TT * 1024 * 4;
constexpr size_t OFF_Z    = OFF_H + (size_t)TT * 1024 * 2;
constexpr size_t OFF_ZH   = OFF_Z;
constexpr size_t OFF_ZHC  = OFF_ZH + (size_t)8 * 1536 * 2048 * 2;
constexpr size_t OFF_QS   = OFF_ZHC + (size_t)8 * 1536 * 256 * 2;
constexpr size_t OFF_KS   = OFF_QS + (size_t)8 * 8 * 2304 * 64 * 2;
constexpr size_t OFF_VTS  = OFF_KS + (size_t)8 * 2 * 2304 * 64 * 2;
constexpr size_t OFF_QN   = OFF_VTS + (size_t)8 * 2 * 2304 * 64 * 2;
constexpr size_t OFF_KN   = OFF_QN + (size_t)8 * 8 * 2304 * 64 * 2;
constexpr size_t OFF_VTN  = OFF_KN + (size_t)8 * 8 * 2304 * 64 * 2;
constexpr size_t OFF_GATE = OFF_VTN + (size_t)8 * 8 * 2304 * 64 * 2;
constexpr size_t OFF_HID  = OFF_Z;
constexpr size_t OFF_Y    = OFF_GATE + (size_t)TT * 3072 * 2;
constexpr size_t OFF_W    = OFF_Y + (size_t)3 * TT * 512 * 2;
constexpr size_t W_GU0 = 0, W_D0 = 5767168, W_GU1 = 8650752, W_D1 = 14417920, W_IN = 17301504, W_B = 24379392, W_O = 25952256, W_END = 27000832;
constexpr size_t WS_NEED  = OFF_W + W_END * 2;

struct Params {
  const float *x, *c, *ctx, *c_ctx, *w_ada, *b_ada, *norm_g, *ffn_wg, *ffn_wu, *ffn_wd, *w_in,
      *hy_short_w, *hy_short_b, *pe_w0, *pe_b0, *pe_w1, *pe_b1, *pe_w2, *pe_b2, *pe_wout, *sin_freq, *hy_bias,
      *swa_qg, *swa_kg, *swa_sink, *na_qg, *na_kg, *na_rpb, *w_branch, *w_out;
  float* out;
  char* ws;
};

DI int opaque_tid() { int t = threadIdx.x; asm volatile("" : "+v"(t)); return t; }
#define TIDX opaque_tid()
#define GAS __attribute__((address_space(1)))
template <class T>
DI GAS T* uptr(T* p) {
  const unsigned long long v = (unsigned long long)p;
  const unsigned lo = __builtin_amdgcn_readfirstlane((unsigned)v), hi = __builtin_amdgcn_readfirstlane((unsigned)(v >> 32));
  return (GAS T*)(((unsigned long long)hi << 32) | lo);
}
DI int opaque0() { int z = 0; asm volatile("" : "+v"(z)); return z; }
typedef __bf16 bf16x2_t __attribute__((ext_vector_type(2)));
DI u16 f2bf(float x) { return __builtin_bit_cast(u16, (__bf16)x); }
DI float bf2f(u16 v) { return __uint_as_float(((unsigned)v) << 16); }
DI unsigned pack2(float a, float b) { bf16x2_t v = {(__bf16)a, (__bf16)b}; return __builtin_bit_cast(unsigned, v); }
DI int crow(int reg, int h) { return (reg & 3) + 8 * (reg >> 2) + 4 * h; }
DI float sigmoidf_(float x) { return __builtin_amdgcn_rcpf(1.f + __expf(-x)); }

#define XB_TMO      128
#define XB_XCNT(j)  (256  + 64 * (j))
#define XB_XSUB(j)  (1280 + 64 * (j))
#define XB_XGEN(j)  (2304 + 64 * (j))
#define XB_TOP      3328
#define XB_TOPGEN   3392
#define XCD_BAR_WORDS 3456
#define XB_SPIN_CAP (1u << 22)
#define LAS __attribute__((address_space(3)))
DI unsigned xb_ld(unsigned* p) { return __hip_atomic_load(p, __ATOMIC_RELAXED, __HIP_MEMORY_SCOPE_AGENT); }
DI unsigned xb_add(unsigned* p, unsigned v) { return __hip_atomic_fetch_add(p, v, __ATOMIC_RELAXED, __HIP_MEMORY_SCOPE_AGENT); }
DI unsigned xb_xcc_id() { return (unsigned)__builtin_amdgcn_s_getreg((3 << 11) | 20) & 0xFu; }
#define XB_SPIN(cond, bar) do { unsigned _sp = 0; while (cond) { __builtin_amdgcn_s_sleep(1); \
    if ((++_sp & 255u) == 0u) { if (xb_ld(&(bar)[XB_TMO])) break; if (_sp > XB_SPIN_CAP) { atomicAdd(&(bar)[XB_TMO], 1u); break; } } } } while (0)
struct XcdBarrier { unsigned* bar; unsigned x; volatile LAS unsigned* st; };
DI XcdBarrier xcd_barrier_post(unsigned* bar, volatile LAS unsigned* st) {
  XcdBarrier b; b.bar = bar; b.x = xb_xcc_id(); b.st = st;
  if (threadIdx.x == 0) (void)xb_add(&bar[XB_XCNT(b.x)], 1u);
  return b;
}
DI void xcd_barrier_complete(unsigned* bar, unsigned x, unsigned& nloc, unsigned& nx) {
  const unsigned G = gridDim.x;
  unsigned sum, cnt, mine, sp = 0u;
  for (;;) {
    sum = 0u; cnt = 0u; mine = 0u;
#pragma unroll
    for (unsigned j = 0; j < 16; ++j) { const unsigned c = xb_ld(&bar[XB_XCNT(j)]); sum += c; cnt += (c > 0u) ? 1u : 0u; mine = (j == x) ? c : mine; }
    if (sum == G) break;
    __builtin_amdgcn_s_sleep(1);
    if ((++sp & 255u) == 0u) { if (xb_ld(&bar[XB_TMO])) break; if (sp > XB_SPIN_CAP) { atomicAdd(&bar[XB_TMO], 1u); break; } }
  }
  nloc = mine > 0u ? mine : 1u; nx = cnt > 0u ? cnt : 1u;
}
DI void xcd_barrier(const XcdBarrier& b) {
  asm volatile("s_waitcnt vmcnt(0)" ::: "memory");
  __syncthreads();
  if (threadIdx.x == 0) {
    unsigned* bar = b.bar;
    __builtin_amdgcn_s_waitcnt(0);
    unsigned nloc = b.st[0], nx = b.st[1];
    if (nloc == 0u) { xcd_barrier_complete(bar, b.x, nloc, nx); b.st[0] = nloc; b.st[1] = nx; }
    const unsigned old = xb_add(&bar[XB_XSUB(b.x)], 1u);
    const unsigned gen = old / nloc;
    if (old + 1u == (gen + 1u) * nloc) {
      __builtin_amdgcn_fence(__ATOMIC_RELEASE, "agent");
      asm volatile("s_waitcnt vmcnt(0)" ::: "memory");
      const unsigned og = xb_add(&bar[XB_TOP], 1u);
      const unsigned tg = og / nx;
      if (og + 1u == (tg + 1u) * nx) xb_add(&bar[XB_TOPGEN], 1u);
      else XB_SPIN(xb_ld(&bar[XB_TOPGEN]) == tg, bar);
      __builtin_amdgcn_fence(__ATOMIC_ACQUIRE, "agent");
      xb_add(&bar[XB_XGEN(b.x)], 1u);
      asm volatile("s_waitcnt vmcnt(0)" ::: "memory");
    } else {
      XB_SPIN(xb_ld(&bar[XB_XGEN(b.x)]) == gen, bar);
      __builtin_amdgcn_fence(__ATOMIC_ACQUIRE, "agent");
      asm volatile("s_waitcnt vmcnt(0)" ::: "memory");
    }
  }
  __syncthreads();
}

DI void mods_partial(const Params& p, char* wsb, int it, char* lds) {
  const int tid = TIDX;
  const int layer = it / 72, rem = it % 72, cgp = rem >> 3, kc = rem & 7;
  float* s = (float*)lds;
  for (int i = tid; i < 9 * 128; i += NTHR) {
    int r = i >> 7, k = kc * 128 + (i & 127);
    float v = r < 8 ? p.c[r * 1024 + k] : p.c_ctx[k];
    s[i] = v / (1.f + __expf(-v));
  }
  __syncthreads();
  const float* w = p.w_ada + (size_t)layer * 1024 * 9216 + (size_t)(kc * 128) * 9216 + cgp * 1024 + tid * 4;
  float acc[9][4];
#pragma unroll
  for (int r = 0; r < 9; ++r) { acc[r][0] = acc[r][1] = acc[r][2] = acc[r][3] = 0.f; }
#pragma unroll 4
  for (int k = 0; k < 128; ++k) {
    const f32x4v wq = NT_LD4(w + (size_t)k * 9216);
    const float4 wv = make_float4(wq[0], wq[1], wq[2], wq[3]);
#pragma unroll
    for (int r = 0; r < 9; ++r) {
      float sv = s[r * 128 + k];
      acc[r][0] += sv * wv.x; acc[r][1] += sv * wv.y; acc[r][2] += sv * wv.z; acc[r][3] += sv * wv.w;
    }
  }
  float* mp = (float*)(wsb + OFF_MODP);
#pragma unroll
  for (int r = 0; r < 9; ++r) {
    float4 o = make_float4(acc[r][0], acc[r][1], acc[r][2], acc[r][3]);
    *(float4*)(mp + ((size_t)((kc * 4 + layer) * 9 + r)) * 9216 + cgp * 1024 + tid * 4) = o;
  }
  __syncthreads();
}

DI void mlp_layer(const float* in, int in_ld, int nin, float* outp, const float* w, const float* bias, const float* freq) {
  const int tid = TIDX, lag = tid >> 3, fg = tid & 7;
  float a8[8];
#pragma unroll
  for (int q = 0; q < 8; ++q) a8[q] = bias[fg * 8 + q];
#pragma unroll 2
  for (int e = 0; e < nin; ++e) {
    float zv = in[lag * in_ld + e];
#pragma unroll
    for (int q = 0; q < 8; ++q) a8[q] += zv * w[e * 64 + fg * 8 + q];
  }
#pragma unroll
  for (int q = 0; q < 8; ++q) outp[lag * 64 + fg * 8 + q] = sinf(freq[fg * 8 + q] * a8[q]);
}

DI void filter_item(const Params& p, char* wsb, int it, char* lds) {
  const int tid = TIDX;
  const int layer = it / 72, ch = it % 72;
  const bool lat = ch < 64;
  const int L = lat ? 2048 : 256;
  const int l0 = lat ? ch * 32 : (ch - 64) * 32;
  float* zs = (float*)lds;
  float* a0 = zs + 32 * 34;
  float* a1 = a0 + 2048;
  {
    int lag = tid >> 3, j = tid & 7, l = l0 + lag;
    float wl = (6.283185307179586f / (float)L) * (float)l;
#pragma unroll
    for (int q = 0; q < 2; ++q) {
      int e = 2 * j + q;
      float f = 1e-4f + (float)e * ((15.f - 1e-4f) / 15.f);
      zs[lag * 34 + 1 + e] = cosf(f * wl);
      zs[lag * 34 + 17 + e] = -sinf(f * wl);
    }
    if (j == 0) zs[lag * 34] = (float)l / (float)(L - 1);
  }
  __syncthreads();
  const float* freq = p.sin_freq + layer * 64;
  mlp_layer(zs, 34, 33, a0, p.pe_w0 + layer * 33 * 64, p.pe_b0 + layer * 64, freq);
  __syncthreads();
  mlp_layer(a0, 64, 64, a1, p.pe_w1 + layer * 64 * 64, p.pe_b1 + layer * 64, freq);
  __syncthreads();
  mlp_layer(a1, 64, 64, a0, p.pe_w2 + layer * 64 * 64, p.pe_b2 + layer * 64, freq);
  __syncthreads();
  const int col0 = tid * 8, os = col0 >> 9, c0 = col0 & 511;
  const float* wout = p.pe_wout + (size_t)layer * 64 * 2048 + col0;
  u16* dstb = lat ? (u16*)(wsb + OFF_FL) + ((size_t)(layer * 4 + os) * 512 + c0) * 2048
                  : (u16*)(wsb + OFF_FC) + ((size_t)(layer * 4 + os) * 512 + c0) * 256;
  const float mind = -3.0701134573253946f, maxd = -15.350567286626973f;
#pragma unroll 1
  for (int g = 0; g < 8; ++g) {
    float acc[4][8];
#pragma unroll
    for (int a = 0; a < 4; ++a)
#pragma unroll
      for (int b = 0; b < 8; ++b) acc[a][b] = 0.f;
#pragma unroll 2
    for (int f = 0; f < 64; ++f) {
      float4 w0 = *(const float4*)(wout + (size_t)f * 2048), w1 = *(const float4*)(wout + (size_t)f * 2048 + 4);
      float wv[8] = {w0.x, w0.y, w0.z, w0.w, w1.x, w1.y, w1.z, w1.w};
#pragma unroll
      for (int lg = 0; lg < 4; ++lg) {
        float av = a0[(4 * g + lg) * 64 + f];
#pragma unroll
        for (int cc = 0; cc < 8; ++cc) acc[lg][cc] += av * wv[cc];
      }
    }
#pragma unroll
    for (int cc = 0; cc < 8; ++cc) {
      float delta = fabsf(mind + (maxd - mind) * ((float)(c0 + cc) / 511.f));
      float v[4];
#pragma unroll
      for (int lg = 0; lg < 4; ++lg) {
        float t = (float)(l0 + 4 * g + lg) / (float)(L - 1);
        v[lg] = acc[lg][cc] * __expf(-t * delta);
      }
      *(uint2*)(dstb + (size_t)cc * L + l0 + 4 * g) = make_uint2(pack2(v[0], v[1]), pack2(v[2], v[3]));
    }
  }
  __syncthreads();
}

DI void rope_item(const Params& p, char* wsb) {
  float* rt = (float*)(wsb + OFF_ROPE);
  for (int i = TIDX; i < 96 * 16; i += NTHR) {
    int pos = i >> 4, j = i & 15;
    float inv = 1.f / powf(10000.f, (float)(2 * j) / 32.f);
    if (pos < 32) { float a = (float)pos * inv; rt[pos * 16 + j] = cosf(a); rt[512 + pos * 16 + j] = sinf(a); }
    else { int cpos = pos - 32; float a = (float)cpos * inv; rt[1024 + cpos * 16 + j] = cosf(a); rt[2048 + cpos * 16 + j] = sinf(a); }
  }
  float* rb = (float*)(wsb + OFF_RPB);
  for (int i = TIDX; i < 4 * 8 * 15 * 160; i += NTHR) {
    int row = i / 160, e = i % 160;
    rb[i] = (e >= 64 && e < 95) ? p.na_rpb[row * 31 + e - 64] : 0.f;
  }
}

DI void phase_prep(const Params& p, char* wsb, char* lds) {
  const int nb = gridDim.x, bid = blockIdx.x, tid = TIDX;
  float4* xs = (float4*)(wsb + OFF_XS);
  const float4* xin = (const float4*)p.x;
  const float4* cin = (const float4*)p.ctx;
  const size_t nl = (size_t)TL * 256, nc = (size_t)TC * 256;
  {
    const size_t stride = (size_t)nb * NTHR;
#pragma unroll 8
    for (size_t i = (size_t)bid * NTHR + tid; i < nl; i += stride) { const f32x4v q = NT_LD4(xin + i); xs[i] = make_float4(q[0], q[1], q[2], q[3]); }
#pragma unroll 8
    for (size_t i = (size_t)bid * NTHR + tid; i < nc; i += stride) { const f32x4v q = NT_LD4(cin + i); xs[nl + i] = make_float4(q[0], q[1], q[2], q[3]); }
  }
  for (int it = bid; it < 577; it += nb) {
    if (it < 288) mods_partial(p, wsb, it, lds);
    else if (it < 576) filter_item(p, wsb, it - 288, lds);
    else rope_item(p, wsb);
  }
}

DI void phase_mods_reduce(const Params& p, char* wsb) {
  float* mods = (float*)(wsb + OFF_MODS);
  const float* mp = (const float*)(wsb + OFF_MODP);
  const int n = 4 * 9 * 9216;
  for (int i = blockIdx.x * NTHR + TIDX; i < n; i += gridDim.x * NTHR) {
    int layer = i / (9 * 9216), col = i % 9216;
    float s = p.b_ada[layer * 9216 + col];
#pragma unroll
    for (int k = 0; k < 8; ++k) s += mp[(size_t)k * n + i];
    mods[i] = s;
  }
}

DI void convert_tile(const float* __restrict__ src, int N, u16* __restrict__ dst, int K, int k0, int n0, int mode, float* t) {
  const int tid = TIDX;
#pragma unroll
  for (int i = 0; i < 4; ++i) {
    int q = tid + NTHR * i, kr = q >> 4, nc = (q & 15) * 4;
    const f32x4v v = NT_LD4(src + (size_t)(k0 + kr) * N + n0 + nc);
    t[kr * 65 + nc] = v[0]; t[kr * 65 + nc + 1] = v[1]; t[kr * 65 + nc + 2] = v[2]; t[kr * 65 + nc + 3] = v[3];
  }
  __syncthreads();
#pragma unroll
  for (int i = 0; i < 2; ++i) {
    int q = tid + NTHR * i, nr = q >> 3, kc = (q & 7) * 8;
    float v[8];
#pragma unroll
    for (int e = 0; e < 8; ++e) v[e] = t[(kc + e) * 65 + nr];
    int n = n0 + nr;
    int dn = mode == 0 ? n : (64 * (n >> 5) + (n & 31) + (mode == 2 ? 32 : 0));
    *(uint4*)(dst + (size_t)dn * K + k0 + kc) = make_uint4(pack2(v[0], v[1]), pack2(v[2], v[3]), pack2(v[4], v[5]), pack2(v[6], v[7]));
  }
  __syncthreads();
}

DI void convert_item(const Params& p, char* wsb, int layer, int it, char* lds) {
  u16* W = (u16*)(wsb + OFF_W);
  const float* src; u16* dst; int K, N, mode = 0, t = it;
  if (t < 4224) {
    int f = t / 2112; t %= 2112;
    int which = t / 704; t %= 704;
    size_t base = (size_t)(layer * 2 + f) * 1024 * 2816;
    if (which == 0) { src = p.ffn_wg + base; dst = W + (f ? W_GU1 : W_GU0); K = 1024; N = 2816; mode = 1; }
    else if (which == 1) { src = p.ffn_wu + base; dst = W + (f ? W_GU1 : W_GU0); K = 1024; N = 2816; mode = 2; }
    else { src = p.ffn_wd + base; dst = W + (f ? W_D1 : W_D0); K = 2816; N = 1024; }
  } else if (t < 4224 + 1728) {
    t -= 4224; src = p.w_in + (size_t)layer * 1024 * 6912; dst = W + W_IN; K = 1024; N = 6912;
  } else if (t < 4224 + 1728 + 384) {
    t -= 5952; int j = t / 128; t %= 128;
    src = p.w_branch + (size_t)(layer * 3 + j) * 512 * 1024; dst = W + W_B + (size_t)j * 1024 * 512; K = 512; N = 1024;
  } else {
    t -= 6336; src = p.w_out + (size_t)layer * 1024 * 1024; dst = W + W_O; K = 1024; N = 1024;
  }
  int ktiles = K >> 6;
  int kt = t % ktiles, nt = t / ktiles;
  convert_tile(src, N, dst, K, kt * 64, nt * 64, mode, (float*)lds);
}

DI void phase_norm(const Params& p, char* wsb, int layer, int which, int mrows, bool do_convert, char* lds) {
  const int tid = TIDX, lane = tid & 63, wid = tid >> 6;
  const float* xs = (const float*)(wsb + OFF_XS);
  u16* H = (u16*)(wsb + OFF_H);
  const float* mods = (const float*)(wsb + OFF_MODS) + (size_t)layer * 9 * 9216;
  const float* g = p.norm_g + (layer * 3 + which) * 1024;
  const int nw = gridDim.x * 4;
#pragma unroll 2
  for (int row = blockIdx.x * 4 + wid; row < mrows; row += nw) {
    const float4* xr = (const float4*)(xs + (size_t)row * 1024);
    float4 v[4];
    float ss = 0.f;
#pragma unroll
    for (int i = 0; i < 4; ++i) { v[i] = xr[lane + 64 * i]; ss += v[i].x * v[i].x + v[i].y * v[i].y + v[i].z * v[i].z + v[i].w * v[i].w; }
#pragma unroll
    for (int o = 32; o; o >>= 1) ss += __shfl_xor(ss, o);
    const float r = rsqrtf(ss * (1.f / 1024.f) + 1e-6f);
    const int mr = row < TL ? (row >> 11) : 8;
    const float* sh = mods + (size_t)mr * 9216 + (3 * which) * 1024;
    const float* sc = sh + 1024;
#pragma unroll
    for (int i = 0; i < 4; ++i) {
      int col = (lane + 64 * i) * 4;
      float4 gg = *(const float4*)(g + col), s4 = *(const float4*)(sh + col), c4 = *(const float4*)(sc + col);
      float o0 = v[i].x * r * gg.x * (1.f + c4.x) + s4.x;
      float o1 = v[i].y * r * gg.y * (1.f + c4.y) + s4.y;
      float o2 = v[i].z * r * gg.z * (1.f + c4.z) + s4.z;
      float o3 = v[i].w * r * gg.w * (1.f + c4.w) + s4.w;
      *(uint2*)(H + (size_t)row * 1024 + col) = make_uint2(pack2(o0, o1), pack2(o2, o3));
    }
  }
  if (do_convert) {
    for (int it = blockIdx.x; it < 6592; it += gridDim.x) convert_item(p, wsb, layer, it, lds);
  }
}

template <int AI, int BI>
DI void gemm_stage(const u16* __restrict__ A, int lda, const u16* __restrict__ B, int ldb, char* buf, int tid) {
#pragma unroll
  for (int i = 0; i < 2 * AI; ++i) {
    const int S = tid + NTHR * i, row = S >> 3, c = (S & 7) ^ ((row >> 1) & 7);
    __builtin_amdgcn_global_load_lds((const unsigned*)(A + (size_t)row * lda + c * 8), (__attribute__((address_space(3))) unsigned*)(buf + S * 16), 16, 0, 0);
  }
#pragma unroll
  for (int i = 0; i < 2 * BI; ++i) {
    const int S = tid + NTHR * i, row = S >> 3, c = (S & 7) ^ ((row >> 1) & 7);
    __builtin_amdgcn_global_load_lds((const unsigned*)(B + (size_t)row * ldb + c * 8), (__attribute__((address_space(3))) unsigned*)(buf + 16384 + S * 16), 16, 0, 0);
  }
}

template <int AI, int BI>
DI void gemm_tile(const u16* __restrict__ A, int lda, const u16* __restrict__ B, int ldb, int nk, bool swap,
                  f32x16 (&acc)[AI][BI], char* lds) {
  const int tid = TIDX, lane = tid & 63, wid = tid >> 6;
  gemm_stage<AI, BI>(A, lda, B, ldb, lds, tid);
  asm volatile("s_waitcnt vmcnt(0)" ::: "memory");
  __syncthreads();
  const int wa = wid >> 1, wb = wid & 1, r = lane & 31, h = lane >> 5, sw = (r >> 1) & 7;
  const int offA = (swap ? 16384 : 0) + (wa * 32 * AI + r) * 128;
  const int offB = (swap ? 0 : 16384) + (wb * 32 * BI + r) * 128;
  for (int kt = 0; kt < nk; ++kt) {
    const char* cur = lds + (kt & 1) * 32768;
    if (kt + 1 < nk) gemm_stage<AI, BI>(A + (kt + 1) * 64, lda, B + (kt + 1) * 64, ldb, lds + ((kt + 1) & 1) * 32768, tid);
#pragma unroll
    for (int ks = 0; ks < 4; ++ks) {
      const int co = ((ks * 2 + h) ^ sw) << 4;
      s16x8 fa[AI], fb[BI];
#pragma unroll
      for (int i = 0; i < AI; ++i) fa[i] = *(const s16x8*)(cur + offA + i * 4096 + co);
#pragma unroll
      for (int i = 0; i < BI; ++i) fb[i] = *(const s16x8*)(cur + offB + i * 4096 + co);
#pragma unroll
      for (int i = 0; i < AI; ++i)
#pragma unroll
        for (int j = 0; j < BI; ++j) acc[i][j] = MFMA(fa[i], fb[j], acc[i][j]);
    }
    asm volatile("s_waitcnt vmcnt(0)" ::: "memory");
    __syncthreads();
  }
}

template <int AI, int BI>
DI void zero_acc(f32x16 (&acc)[AI][BI]) {
#pragma unroll
  for (int a = 0; a < AI; ++a)
#pragma unroll
    for (int b = 0; b < BI; ++b)
#pragma unroll
      for (int i = 0; i < 16; ++i) acc[a][b][i] = 0.f;
}

DI void gemm_stage_w(const u16* __restrict__ A, int lda, const u16* __restrict__ B, int ldb, char* buf, int tid) {
#pragma unroll
  for (int i = 0; i < 2; ++i) {
    const int S = tid + NTHR * i, row = S >> 2, c = (S & 3) ^ ((row >> 2) & 3);
    __builtin_amdgcn_global_load_lds((const unsigned*)(A + (size_t)row * lda + c * 8), (__attribute__((address_space(3))) unsigned*)(buf + S * 16), 16, 0, 0);
  }
#pragma unroll
  for (int i = 0; i < 4; ++i) {
    const int S = tid + NTHR * i, row = S >> 2, c = (S & 3) ^ ((row >> 2) & 3);
    __builtin_amdgcn_global_load_lds((const unsigned*)(B + (size_t)row * ldb + c * 8), (__attribute__((address_space(3))) unsigned*)(buf + 8192 + S * 16), 16, 0, 0);
  }
}
DI void gemm_tile_w(const u16* __restrict__ A, int lda, const u16* __restrict__ B, int ldb, int nk, bool swap,
                    f32x16 (&acc)[2][4], char* lds) {
  const int tid = TIDX, lane = tid & 63, wid = tid >> 6;
  gemm_stage_w(A, lda, B, ldb, lds, tid);
  asm volatile("s_waitcnt vmcnt(0)" ::: "memory");
  __syncthreads();
  const int r = lane & 31, h = lane >> 5, sw = (r >> 2) & 3;
  const int wa = swap ? wid : (wid >> 1), wb = swap ? 0 : (wid & 1);
  const int offF = (swap ? 8192 : 0) + (wa * 64 + r) * 64;
  const int offS = (swap ? 0 : 8192) + (wb * 128 + r) * 64;
  for (int kt = 0; kt < nk; ++kt) {
    const char* cur = lds + (kt & 1) * 24576;
    if (kt + 1 < nk) gemm_stage_w(A + (kt + 1) * 32, lda, B + (kt + 1) * 32, ldb, lds + ((kt + 1) & 1) * 24576, tid);
#pragma unroll
    for (int ks = 0; ks < 2; ++ks) {
      const int co = ((ks * 2 + h) ^ sw) << 4;
      s16x8 f0 = *(const s16x8*)(cur + offF + co), f1 = *(const s16x8*)(cur + offF + 2048 + co);
#pragma unroll
      for (int si = 0; si < 4; ++si) {
        s16x8 sb = *(const s16x8*)(cur + offS + si * 2048 + co);
        acc[0][si] = MFMA(f0, sb, acc[0][si]);
        acc[1][si] = MFMA(f1, sb, acc[1][si]);
      }
    }
    asm volatile("s_waitcnt vmcnt(0)" ::: "memory");
    __syncthreads();
  }
}
DI void zero_acc_w(f32x16 (&acc)[2][4]) {
#pragma unroll
  for (int a = 0; a < 2; ++a)
#pragma unroll
    for (int b = 0; b < 4; ++b)
#pragma unroll
      for (int i = 0; i < 16; ++i) acc[a][b][i] = 0.f;
}

DI bool next_tile(int rnd, int MT, int NT, int& mt, int& nt) {
  const int G8 = gridDim.x >> 3, x = blockIdx.x & 7, slot = blockIdx.x >> 3;
  const int T = (rnd * 8 + x) * G8 + slot;
  if (T >= MT * NT) return false;
  const int band = T / (NT * 8), rem = T - band * NT * 8;
  nt = rem >> 3; mt = band * 8 + (rem & 7);
  return true;
}

template <int AI>
DI void gu_tile(char* wsb, int sub, int m0, int n0, char* lds) {
  const u16* H = (const u16*)(wsb + OFF_H);
  const u16* W = (const u16*)(wsb + OFF_W) + (sub ? W_GU1 : W_GU0);
  u16* HID = (u16*)(wsb + OFF_HID);
  const int lane = TIDX & 63, wid = TIDX >> 6, wa = wid >> 1, wb = wid & 1, r = lane & 31, h = lane >> 5;
  f32x16 acc[AI][2]; zero_acc<AI, 2>(acc);
  gemm_tile<AI, 2>(H + (size_t)m0 * 1024, 1024, W + (size_t)n0 * 1024, 1024, 16, false, acc, lds);
  const int m0e = m0 + opaque0();
  const int hc = (n0 >> 1) + wb * 32 + r;
  GAS u16* HIDu = uptr(HID);
  const unsigned ib = (unsigned)((m0e + wa * 32 * AI + 4 * h) * 2816 + hc);
#pragma unroll
  for (int ai = 0; ai < AI; ++ai)
#pragma unroll
    for (int reg = 0; reg < 16; ++reg) {
      float g = acc[ai][0][reg], u = acc[ai][1][reg];
      float v = g * __builtin_amdgcn_rcpf(1.f + __expf(-g)) * u;
      HIDu[ib + (unsigned)((ai * 32 + (reg & 3) + 8 * (reg >> 2)) * 2816)] = f2bf(v);
      if ((reg & 7) == 7) __builtin_amdgcn_sched_barrier(0);
    }
}
DI void phase_gu(const Params& p, char* wsb, int sub, int mrows, char* lds) {
  int mt, nt;
  for (int rnd = 0; next_tile(rnd, 128, 44, mt, nt); ++rnd) gu_tile<2>(wsb, sub, mt * 128, nt * 128, lds);
  if (mrows > TL)
    for (int rnd = 0; next_tile(rnd, 32, 44, mt, nt); ++rnd) gu_tile<1>(wsb, sub, TL + mt * 64, nt * 128, lds);
}

template <int AI, int BI>
DI void dn_tile(const Params& p, char* wsb, int layer, int sub, bool final_out, int m0, int n0, char* lds) {
  const u16* HID = (const u16*)(wsb + OFF_HID);
  const u16* W = (const u16*)(wsb + OFF_W) + (sub ? W_D1 : W_D0);
  float* xs = (float*)(wsb + OFF_XS);
  const float* mods = (const float*)(wsb + OFF_MODS) + (size_t)layer * 9 * 9216;
  const int lane = TIDX & 63, wid = TIDX >> 6, wa = wid >> 1, wb = wid & 1, r = lane & 31, h = lane >> 5;
  f32x16 acc[AI][BI]; zero_acc<AI, BI>(acc);
  gemm_tile<AI, BI>(HID + (size_t)m0 * 2816, 2816, W + (size_t)n0 * 2816, 2816, 44, false, acc, lds);
  const int m0e = m0 + opaque0();
  const int mr = m0 < TL ? (m0 >> 11) : 8;
  const float* gate = mods + (size_t)mr * 9216 + (2 + 6 * sub) * 1024;
  GAS float* xsu = uptr(xs);
  GAS float* outu = uptr(p.out);
#pragma unroll
  for (int bi = 0; bi < BI; ++bi) {
    const int n = n0 + wb * 32 * BI + bi * 32 + r;
    const float gv = 0.5f * gate[n];
    const unsigned ib = (unsigned)((m0e + wa * 32 * AI + 4 * h) * 1024 + n);
#pragma unroll
    for (int ai = 0; ai < AI; ++ai)
#pragma unroll
      for (int reg = 0; reg < 16; ++reg) {
        const unsigned idx = ib + (unsigned)((ai * 32 + (reg & 3) + 8 * (reg >> 2)) * 1024);
        float v = xsu[idx] + gv * acc[ai][bi][reg];
        if (final_out) outu[idx] = v; else xsu[idx] = v;
        if ((reg & 7) == 7) __builtin_amdgcn_sched_barrier(0);
      }
  }
}
DI void phase_dn(const Params& p, char* wsb, int layer, int sub, int mrows, bool final_out, char* lds) {
  int mt, nt;
  for (int rnd = 0; next_tile(rnd, 128, 8, mt, nt); ++rnd) dn_tile<2, 2>(p, wsb, layer, sub, final_out, mt * 128, nt * 128, lds);
  if (mrows > TL)
    for (int rnd = 0; next_tile(rnd, 32, 16, mt, nt); ++rnd) dn_tile<1, 1>(p, wsb, layer, sub, final_out, TL + mt * 64, nt * 64, lds);
}

DI void phase_in(const Params& p, char* wsb, int layer, char* lds) {
  const u16* H = (const u16*)(wsb + OFF_H);
  const u16* W = (const u16*)(wsb + OFF_W) + W_IN;
  const float* rope = (const float*)(wsb + OFF_ROPE);
  const int lane = TIDX & 63, wid = TIDX >> 6, wa = wid >> 1, wb = wid & 1, r = lane & 31, h = lane >> 5;
  int mt, nt;
  for (int rnd = 0; next_tile(rnd, 144, 54, mt, nt); ++rnd) {
    const int m0 = mt * 128, n0 = nt * 128;
    if (layer == 3 && m0 >= TL && !(n0 == 2048 || n0 == 2176 || (n0 >= 2816 && n0 < 3840))) continue;
    const bool swap = n0 < 3840;
    f32x16 acc[2][2]; zero_acc<2, 2>(acc);
    gemm_tile<2, 2>(H + (size_t)m0 * 1024, 1024, W + (size_t)n0 * 1024, 1024, 16, swap, acc, lds);
    const int m0e = m0 + opaque0();
    if (!swap) {
      GAS u16* G = uptr((u16*)(wsb + OFF_GATE));
#pragma unroll
      for (int bi = 0; bi < 2; ++bi) {
        const int n = n0 - 3840 + wb * 64 + bi * 32 + r;
        const unsigned ib = (unsigned)((m0e + wa * 64 + 4 * h) * 3072 + n);
#pragma unroll
        for (int ai = 0; ai < 2; ++ai)
#pragma unroll
          for (int reg = 0; reg < 16; ++reg)
            G[ib + (unsigned)((ai * 32 + (reg & 3) + 8 * (reg >> 2)) * 3072)] = f2bf(sigmoidf_(acc[ai][bi][reg]));
      }
      continue;
    }
    const bool isctx = m0 >= TL;
    if (n0 < 1536) {
#pragma unroll
      for (int bi = 0; bi < 2; ++bi) {
        const int m = m0e + wb * 64 + bi * 32 + r;
        u16* dst; size_t tstride;
        if (!isctx) { int b = m >> 11, t = m & 2047; dst = (u16*)(wsb + OFF_ZH) + (size_t)b * 1536 * 2048 + t; tstride = 2048; }
        else { int mm = m - TL; int b = mm >> 8, t = mm & 255; dst = (u16*)(wsb + OFF_ZHC) + (size_t)b * 1536 * 256 + t; tstride = 256; }
#pragma unroll
        for (int ai = 0; ai < 2; ++ai)
#pragma unroll
          for (int reg = 0; reg < 16; ++reg) {
            int n = n0 + wa * 64 + ai * 32 + crow(reg, h);
            dst[(size_t)n * tstride] = f2bf(acc[ai][bi][reg]);
          }
      }
      continue;
    }
    int kind, head;
    bool na;
    {
      int nn = n0 + wa * 64;
      if (nn < 2304) { na = false; int o = nn - 1536; if (o < 512) { kind = 0; head = o >> 6; } else if (o < 640) { kind = 1; head = (o - 512) >> 6; } else { kind = 2; head = (o - 640) >> 6; } }
      else { na = true; int o = nn - 2304; kind = o >> 9; head = (o & 511) >> 6; }
    }
    const int nheads = (!na && kind != 0) ? 2 : 8;
#pragma unroll
    for (int bi = 0; bi < 2; ++bi) {
      const int m = m0e + wb * 64 + bi * 32 + r;
      int b, tok, pos;
      if (!isctx) { b = m >> 11; pos = m & 2047; tok = pos; } else { int mm = m - TL; b = mm >> 8; pos = 0; tok = 2048 + (mm & 255); }
      if (kind == 2) {
        u16* dst = (u16*)(wsb + (na ? OFF_VTN : OFF_VTS)) + ((size_t)(b * nheads + head) * 64) * 2304 + tok;
#pragma unroll
        for (int ai = 0; ai < 2; ++ai)
#pragma unroll
          for (int reg = 0; reg < 16; ++reg) {
            int d = ai * 32 + crow(reg, h);
            dst[(size_t)d * 2304] = f2bf(acc[ai][bi][reg]);
          }
      } else {
        const float* gain = (na ? (kind == 0 ? p.na_qg : p.na_kg) : (kind == 0 ? p.swa_qg : p.swa_kg)) + layer * 64;
        float ss = 0.f;
#pragma unroll
        for (int ai = 0; ai < 2; ++ai)
#pragma unroll
          for (int reg = 0; reg < 16; ++reg) ss += acc[ai][bi][reg] * acc[ai][bi][reg];
        ss += __shfl_xor(ss, 32);
        const float rn = rsqrtf(ss * (1.f / 64.f) + 1e-6f);
        float v[2][16];
#pragma unroll
        for (int ai = 0; ai < 2; ++ai)
#pragma unroll
          for (int reg = 0; reg < 16; ++reg) v[ai][reg] = acc[ai][bi][reg] * rn * gain[ai * 32 + crow(reg, h)];
        if (!na && !isctx) {
          const int prow = pos >> 6, pcol = pos & 63;
#pragma unroll
          for (int ai = 0; ai < 2; ++ai) {
            const float* ct = ai == 0 ? rope + prow * 16 : rope + 1024 + pcol * 16;
            const float* st = ai == 0 ? rope + 512 + prow * 16 : rope + 2048 + pcol * 16;
#pragma unroll
            for (int reg = 0; reg < 8; ++reg) {
              int j = crow(reg, h);
              float cs = ct[j], sn = st[j];
              float x1 = v[ai][reg], x2 = v[ai][reg + 8];
              v[ai][reg] = x1 * cs - x2 * sn;
              v[ai][reg + 8] = x2 * cs + x1 * sn;
            }
          }
        }
        const float qs = kind == 0 ? 0.125f : 1.f;
        u16* dst = (u16*)(wsb + (na ? (kind == 0 ? OFF_QN : OFF_KN) : (kind == 0 ? OFF_QS : OFF_KS))) +
                   ((size_t)(b * nheads + head) * 2304 + tok) * 64;
#pragma unroll
        for (int ai = 0; ai < 2; ++ai)
#pragma unroll
          for (int g4 = 0; g4 < 4; ++g4) {
            int d0 = ai * 32 + 8 * g4 + 4 * h;
            *(uint2*)(dst + d0) = make_uint2(pack2(v[ai][4 * g4] * qs, v[ai][4 * g4 + 1] * qs), pack2(v[ai][4 * g4 + 2] * qs, v[ai][4 * g4 + 3] * qs));
          }
      }
    }
  }
}

template <int AI, int BI>
DI void m1_tile(char* wsb, int m0, int n0, char* lds) {
  const u16* Y = (const u16*)(wsb + OFF_Y);
  const u16* W = (const u16*)(wsb + OFF_W) + W_B;
  const u16* G = (const u16*)(wsb + OFF_GATE);
  u16* GM = (u16*)(wsb + OFF_H);
  const int tid = TIDX, lane = tid & 63, wid = tid >> 6, wa = wid >> 1, wb = wid & 1, r = lane & 31, h = lane >> 5, sw = (r >> 1) & 7;
  f32x16 tot[AI][BI], acc[AI][BI];
  zero_acc<AI, BI>(tot); zero_acc<AI, BI>(acc);
  const u16* Wt = W + (size_t)n0 * 512;
  const u16* Yt = Y + (size_t)m0 * 512;
  gemm_stage<AI, BI>(Wt, 512, Yt, 512, lds, tid);
  asm volatile("s_waitcnt vmcnt(0)" ::: "memory");
  __syncthreads();
  const int offA = (wa * 32 * AI + r) * 128;
  const int offB = 16384 + (wb * 32 * BI + r) * 128;
  uint2 gq[AI][BI][4];
#pragma unroll 1
  for (int kt = 0; kt < 24; ++kt) {
    const char* cur = lds + (kt & 1) * 32768;
    const int j = kt >> 3, kk = kt & 7;
    if (kt + 1 < 24) {
      const int j1 = (kt + 1) >> 3, k1 = (kt + 1) & 7;
      gemm_stage<AI, BI>(Wt + (size_t)j1 * 1024 * 512 + k1 * 64, 512, Yt + (size_t)j1 * TT * 512 + k1 * 64, 512, lds + ((kt + 1) & 1) * 32768, tid);
    }
    if (kk == 0) {
#pragma unroll
      for (int bi = 0; bi < BI; ++bi) {
        const size_t m = (size_t)(m0 + wb * 32 * BI + bi * 32 + r);
#pragma unroll
        for (int ai = 0; ai < AI; ++ai)
#pragma unroll
          for (int g4 = 0; g4 < 4; ++g4)
            gq[ai][bi][g4] = *(const uint2*)(G + m * 3072 + j * 1024 + n0 + wa * 32 * AI + ai * 32 + 8 * g4 + 4 * h);
      }
    }
#pragma unroll
    for (int ks = 0; ks < 4; ++ks) {
      const int co = ((ks * 2 + h) ^ sw) << 4;
      s16x8 fa[AI], fb[BI];
#pragma unroll
      for (int i = 0; i < AI; ++i) fa[i] = *(const s16x8*)(cur + offA + i * 4096 + co);
#pragma unroll
      for (int i = 0; i < BI; ++i) fb[i] = *(const s16x8*)(cur + offB + i * 4096 + co);
#pragma unroll
      for (int i = 0; i < AI; ++i)
#pragma unroll
        for (int jj = 0; jj < BI; ++jj) acc[i][jj] = MFMA(fa[i], fb[jj], acc[i][jj]);
    }
    if (kk == 7) {
#pragma unroll
      for (int ai = 0; ai < AI; ++ai)
#pragma unroll
        for (int bi = 0; bi < BI; ++bi)
#pragma unroll
          for (int g4 = 0; g4 < 4; ++g4) {
            const uint2 gv = gq[ai][bi][g4];
            tot[ai][bi][4 * g4 + 0] += bf2f((u16)(gv.x & 0xffff)) * acc[ai][bi][4 * g4 + 0];
            tot[ai][bi][4 * g4 + 1] += bf2f((u16)(gv.x >> 16)) * acc[ai][bi][4 * g4 + 1];
            tot[ai][bi][4 * g4 + 2] += bf2f((u16)(gv.y & 0xffff)) * acc[ai][bi][4 * g4 + 2];
            tot[ai][bi][4 * g4 + 3] += bf2f((u16)(gv.y >> 16)) * acc[ai][bi][4 * g4 + 3];
          }
      zero_acc<AI, BI>(acc);
    }
    asm volatile("s_waitcnt vmcnt(0)" ::: "memory");
    __syncthreads();
  }
  const int m0f = m0 + opaque0();
#pragma unroll
  for (int bi = 0; bi < BI; ++bi) {
    const size_t m = (size_t)(m0f + wb * 32 * BI + bi * 32 + r);
#pragma unroll
    for (int ai = 0; ai < AI; ++ai)
#pragma unroll
      for (int g4 = 0; g4 < 4; ++g4)
        *(uint2*)(GM + m * 1024 + n0 + wa * 32 * AI + ai * 32 + 8 * g4 + 4 * h) =
            make_uint2(pack2(tot[ai][bi][4 * g4], tot[ai][bi][4 * g4 + 1]), pack2(tot[ai][bi][4 * g4 + 2], tot[ai][bi][4 * g4 + 3]));
  }
}
DI void phase_m1(const Params& p, char* wsb, int mrows, char* lds) {
  int mt, nt;
  for (int rnd = 0; next_tile(rnd, 128, 8, mt, nt); ++rnd) m1_tile<2, 2>(wsb, mt * 128, nt * 128, lds);
  if (mrows > TL)
    for (int rnd = 0; next_tile(rnd, 32, 16, mt, nt); ++rnd) m1_tile<1, 1>(wsb, TL + mt * 64, nt * 64, lds);
}

template <int AI, int BI>
DI void m2_tile(char* wsb, int layer, int m0, int n0, char* lds) {
  const u16* GM = (const u16*)(wsb + OFF_H);
  const u16* W = (const u16*)(wsb + OFF_W) + W_O;
  float* xs = (float*)(wsb + OFF_XS);
  const float* mods = (const float*)(wsb + OFF_MODS) + (size_t)layer * 9 * 9216;
  const int lane = TIDX & 63, wid = TIDX >> 6, wa = wid >> 1, wb = wid & 1, r = lane & 31, h = lane >> 5;
  f32x16 acc[AI][BI]; zero_acc<AI, BI>(acc);
  gemm_tile<AI, BI>(GM + (size_t)m0 * 1024, 1024, W + (size_t)n0 * 1024, 1024, 16, false, acc, lds);
  const int m0e = m0 + opaque0();
  const int mr = m0 < TL ? (m0 >> 11) : 8;
  const float* gate = mods + (size_t)mr * 9216 + 5 * 1024;
  GAS float* xsu = uptr(xs);
#pragma unroll
  for (int bi = 0; bi < BI; ++bi) {
    const int n = n0 + wb * 32 * BI + bi * 32 + r;
    const float gv = gate[n];
    const unsigned ib = (unsigned)((m0e + wa * 32 * AI + 4 * h) * 1024 + n);
#pragma unroll
    for (int ai = 0; ai < AI; ++ai)
#pragma unroll
      for (int reg = 0; reg < 16; ++reg) {
        const unsigned idx = ib + (unsigned)((ai * 32 + (reg & 3) + 8 * (reg >> 2)) * 1024);
        xsu[idx] += gv * acc[ai][bi][reg];
        if ((reg & 7) == 7) __builtin_amdgcn_sched_barrier(0);
      }
  }
}
DI void phase_m2(const Params& p, char* wsb, int layer, int mrows, char* lds) {
  int mt, nt;
  for (int rnd = 0; next_tile(rnd, 128, 8, mt, nt); ++rnd) m2_tile<2, 2>(wsb, layer, mt * 128, nt * 128, lds);
  if (mrows > TL)
    for (int rnd = 0; next_tile(rnd, 32, 16, mt, nt); ++rnd) m2_tile<1, 1>(wsb, layer, TL + mt * 64, nt * 64, lds);
}

DI float sconv(const u16* z, int t, int L, float w0, float w1, float w2, float bb) {
  float zm = t > 0 ? bf2f(z[t - 1]) : 0.f, z0 = bf2f(z[t]), zp = t + 1 < L ? bf2f(z[t + 1]) : 0.f;
  return w0 * zm + w1 * z0 + w2 * zp + bb;
}

template <int NB1>
DI void hyena_item(const Params& p, char* wsb, int layer, int c, char* lds) {
  constexpr int L = NB1 * 32;
  constexpr int TPW = NB1 == 64 ? 4 : 1;
  const int tid = TIDX, lane = tid & 63, wid = tid >> 6, r = lane & 31, h = lane >> 5;
  u16* U = (u16*)lds;
  u16* R = (u16*)(lds + 40960);
  const u16* zbase = NB1 == 64 ? (const u16*)(wsb + OFF_ZH) : (const u16*)(wsb + OFF_ZHC);
  const float* sw = p.hy_short_w + layer * 3 * 1536;
  const float* sb = p.hy_short_b + layer * 1536;
  {
    const float w0 = sw[c], w1 = sw[1536 + c], w2 = sw[3072 + c], bb = sb[c];
#pragma unroll 2
    for (int ch = tid; ch < L; ch += NTHR) {
      const int b = ch / (L / 8), t = (ch % (L / 8)) * 8;
      const u16* zr = zbase + ((size_t)(b * 1536 + c)) * L;
      const uint4 zz = *(const uint4*)(zr + t);
      const float zm1 = bf2f(zr[t > 0 ? t - 1 : 0]) * (t > 0 ? 1.f : 0.f);
      const float zp8 = bf2f(zr[t + 8 < L ? t + 8 : L - 1]) * (t + 8 < L ? 1.f : 0.f);
      const unsigned zw[4] = {zz.x, zz.y, zz.z, zz.w};
      float zv[10];
      zv[0] = zm1; zv[9] = zp8;
#pragma unroll
      for (int q = 0; q < 4; ++q) { zv[1 + 2 * q] = bf2f((u16)(zw[q] & 0xffff)); zv[2 + 2 * q] = bf2f((u16)(zw[q] >> 16)); }
      float o[8];
#pragma unroll
      for (int e = 0; e < 8; ++e) o[e] = w0 * zv[e] + w1 * zv[e + 1] + w2 * zv[e + 2] + bb;
      *(uint4*)(U + (b * NB1 + (t >> 5)) * 40 + (t & 31)) = make_uint4(pack2(o[0], o[1]), pack2(o[2], o[3]), pack2(o[4], o[5]), pack2(o[6], o[7]));
    }
  }
  if (NB1 == 64) {
    unsigned acc_t = 0;
#pragma unroll
    for (int q = 0; q < 4; ++q) {
      const int b = 2 * wid + (q & 1), xc = (q >> 1 ? 1024 : 512) + c;
      const unsigned* rowp = (const unsigned*)(zbase + ((size_t)(b * 1536 + xc)) * L);
      acc_t += rowp[(lane & 31) * 32 + (lane >> 5) * 16];
    }
    asm volatile("" ::"v"(acc_t));
  }
  const bool active = NB1 == 64 ? true : (wid < 2);
  const u16* filt = NB1 == 64 ? (const u16*)(wsb + OFF_FL) : (const u16*)(wsb + OFF_FC);
  int tb[TPW], tt1[TPW];
#pragma unroll
  for (int j = 0; j < TPW; ++j) { int col = (wid * TPW + j) * 32 + r; tb[j] = col / NB1; tt1[j] = col % NB1; }
  int ub[TPW];
#pragma unroll
  for (int j = 0; j < TPW; ++j) ub[j] = ((tb[j] * NB1 + tt1[j]) * 40 + 8 * h) * 2;
  const int zaddr = 40960 + 2 * L * 2 + 64;
  const int pbase = (L - 1) - r + 8 * h;
  const unsigned sh = (unsigned)(pbase & 1) << 4;
  const unsigned* Rd = (const unsigned*)R + (pbase >> 1);
#pragma unroll 1
  for (int order = 0; order < 2; ++order) {
    __syncthreads();
    {
      const u16* fp = filt + ((size_t)((layer * 4 + order * 2 + 0) * 512 + c)) * L;
      const u16* fn = filt + ((size_t)((layer * 4 + order * 2 + 1) * 512 + c)) * L;
      for (int ch = tid; ch < (2 * L + 64) / 8; ch += NTHR) {
        const int i0 = ch * 8;
        uint4 o;
        if (i0 < L) {
          const uint4 v = *(const uint4*)(fp + (L - 8 - i0));
          o.x = (v.w >> 16) | (v.w << 16); o.y = (v.z >> 16) | (v.z << 16); o.z = (v.y >> 16) | (v.y << 16); o.w = (v.x >> 16) | (v.x << 16);
        } else {
          unsigned e8[8];
#pragma unroll
          for (int e = 0; e < 8; ++e) { const int i = i0 + e; e8[e] = i <= 2 * L - 2 ? (unsigned)fn[i - (L - 1)] : 0u; }
          o.x = e8[0] | (e8[1] << 16); o.y = e8[2] | (e8[3] << 16); o.z = e8[4] | (e8[5] << 16); o.w = e8[6] | (e8[7] << 16);
        }
        *(uint4*)(R + i0) = o;
      }
    }
    __syncthreads();
    if (active) {
      const int xcol = (order == 0 ? 512 : 1024) + c;
      const float w0 = sw[xcol], w1 = sw[1536 + xcol], w2 = sw[3072 + xcol], bb = sb[xcol];
      const float bias = p.hy_bias[(layer * 2 + order) * 512 + c];
      f32x16 acc[TPW];
#pragma unroll
      for (int j = 0; j < TPW; ++j)
#pragma unroll
        for (int i = 0; i < 16; ++i) acc[j][i] = 0.f;
      auto d1_range = [&](const int lo, const int hi, const int jmask) {
#pragma unroll 1
        for (int d1o = lo; d1o < hi; d1o += 2) {
#pragma unroll
          for (int dk = 0; dk < 4; ++dk) {
            const int d1 = d1o + (dk >> 1), ks = dk & 1;
            const unsigned* rp = Rd + (-16 * d1 + 8 * ks);
            unsigned w[5];
#pragma unroll
            for (int q = 0; q < 5; ++q) w[q] = rp[q];
            union { s16x8 v; unsigned u[4]; } af;
#pragma unroll
            for (int q = 0; q < 4; ++q) af.u[q] = __builtin_amdgcn_alignbit(w[q + 1], w[q], sh);
#pragma unroll
            for (int j = 0; j < TPW; ++j) {
              if (!((jmask >> (j & 1)) & 1)) continue;
              const bool ok = (unsigned)(tt1[j] - d1) < (unsigned)NB1;
              const int addr = ok ? ub[j] - d1 * 80 + ks * 32 : zaddr;
              const s16x8 bf = *(const s16x8*)(lds + addr);
              acc[j] = MFMA(af.v, bf, acc[j]);
            }
          }
        }
      };
      if (NB1 == 64) { d1_range(-64, -32, 1); d1_range(-32, 32, 3); d1_range(32, 64, 2); }
      else d1_range(-NB1, NB1, 3);
#pragma unroll
      for (int j = 0; j < TPW; ++j) {
        const u16* zr = zbase + ((size_t)(tb[j] * 1536 + xcol)) * L;
#pragma unroll
        for (int g4 = 0; g4 < 4; ++g4) {
          const int t0 = 8 * g4 + 4 * h, t = 32 * tt1[j] + t0;
          const int uidx = (tb[j] * NB1 + tt1[j]) * 40 + t0;
          const uint2 uu = *(const uint2*)(U + uidx);
          const uint2 zz = *(const uint2*)(zr + t);
          const float zm1 = t > 0 ? bf2f(zr[t - 1]) : 0.f;
          const float zp4 = t + 4 < L ? bf2f(zr[t + 4]) : 0.f;
          const float zv[6] = {zm1, bf2f((u16)(zz.x & 0xffff)), bf2f((u16)(zz.x >> 16)), bf2f((u16)(zz.y & 0xffff)), bf2f((u16)(zz.y >> 16)), zp4};
          const float uv[4] = {bf2f((u16)(uu.x & 0xffff)), bf2f((u16)(uu.x >> 16)), bf2f((u16)(uu.y & 0xffff)), bf2f((u16)(uu.y >> 16))};
          float yv[4];
#pragma unroll
          for (int e = 0; e < 4; ++e) {
            const float xv = w0 * zv[e] + w1 * zv[e + 1] + w2 * zv[e + 2] + bb;
            yv[e] = xv * (acc[j][4 * g4 + e] + bias * uv[e]);
          }
          if (order == 0) *(uint2*)(U + uidx) = make_uint2(pack2(yv[0], yv[1]), pack2(yv[2], yv[3]));
          else {
            const size_t row = NB1 == 64 ? (size_t)tb[j] * 2048 + t : (size_t)TL + tb[j] * 256 + t;
            u16* yo = (u16*)(wsb + OFF_Y) + row * 512 + c;
#pragma unroll
            for (int e = 0; e < 4; ++e) yo[(size_t)e * 512] = f2bf(yv[e]);
          }
        }
      }
    }
  }
}

template <int MODE>
DI void attn_wave(const u16* __restrict__ Q, const u16* __restrict__ K, const u16* __restrict__ Vt, u16* __restrict__ Yout,
                  int qpos0, const float* rpb, float sink, bool has_sink) {
  const int lane = TIDX & 63, r = lane & 31, h = lane >> 5;
  s16x8 qf[4];
#pragma unroll
  for (int ks = 0; ks < 4; ++ks) qf[ks] = *(const s16x8*)(Q + r * 64 + ks * 16 + h * 8);
  f32x16 O0, O1;
#pragma unroll
  for (int i = 0; i < 16; ++i) { O0[i] = 0.f; O1[i] = 0.f; }
  float mrun = -INFINITY, lrun = 0.f;
  int nloc = 0, jlo = 0, qr = 0, qc = 0, rs = 0;
  if (MODE == 0) {
    jlo = qpos0 < 128 ? (128 - qpos0) >> 5 : 0;
    const int jhi = min(8, (2047 - (qpos0 - 128)) >> 5);
    nloc = jhi - jlo + 1;
  } else if (MODE == 1) {
    qr = qpos0 >> 6; qc = (qpos0 & 63) + r; rs = min(max(qr - 4, 0), 24); nloc = 16;
  }
  const int ntiles = 8 + nloc;
  auto tile_kb = [&](int i) -> int {
    if (i < 8) return 2048 + i * 32;
    const int j = i - 8;
    if (MODE == 0) return qpos0 - 128 + 32 * (jlo + j);
    return (rs + (j >> 1)) * 64 + 32 * (j & 1);
  };
  const u16* kbase = K + (size_t)r * 64 + h * 8;
  const u16* vbase = Vt + (size_t)r * 2304 + 4 * h;
  s16x8 kf[4];
  {
    const int kb = tile_kb(0);
#pragma unroll
    for (int ks = 0; ks < 4; ++ks) kf[ks] = *(const s16x8*)(kbase + (size_t)kb * 64 + ks * 16);
  }
#pragma unroll 1
  for (int i = 0; i < ntiles; ++i) {
    const int kb = tile_kb(i);
    union { s16x8 v; uint2 u[2]; } v0[2], v1[2];
#pragma unroll
    for (int s2 = 0; s2 < 2; ++s2) {
      const u16* vp0 = vbase + kb + 16 * s2;
      const u16* vp1 = vp0 + (size_t)32 * 2304;
      v0[s2].u[0] = *(const uint2*)vp0; v0[s2].u[1] = *(const uint2*)(vp0 + 8);
      v1[s2].u[0] = *(const uint2*)vp1; v1[s2].u[1] = *(const uint2*)(vp1 + 8);
    }
    s16x8 kn[4];
    {
      const int kbn = tile_kb(i + 1 < ntiles ? i + 1 : i);
#pragma unroll
      for (int ks = 0; ks < 4; ++ks) kn[ks] = *(const s16x8*)(kbase + (size_t)kbn * 64 + ks * 16);
    }
    f32x16 S;
#pragma unroll
    for (int q = 0; q < 16; ++q) S[q] = 0.f;
#pragma unroll
    for (int ks = 0; ks < 4; ++ks) S = MFMA(kf[ks], qf[ks], S);
    if (i >= 8) {
      if (MODE == 0) {
        const int d0 = (qpos0 + r) - (kb + 4 * h);
#pragma unroll
        for (int reg = 0; reg < 16; ++reg) { const int d = d0 - ((reg & 3) + 8 * (reg >> 2)); if (d > 128 || d < -128) S[reg] = -INFINITY; }
      } else if (MODE == 1) {
        const int j = i - 8;
        const float* brow = rpb + ((rs + (j >> 1)) - qr + 7) * 160 + 64;
        const int cstart = min(max(qc - 8, 0), 48);
        const int kc0 = 32 * (j & 1) + 4 * h;
        const float* bp = brow + (kc0 - qc + 15);
        const int rel = kc0 - cstart;
#pragma unroll
        for (int reg = 0; reg < 16; ++reg) {
          const int o = (reg & 3) + 8 * (reg >> 2);
          const bool ok = (unsigned)(rel + o) < 16u;
          S[reg] = ok ? S[reg] + bp[o] : -INFINITY;
        }
      }
    }
    float mx = S[0];
#pragma unroll
    for (int reg = 1; reg < 16; ++reg) mx = fmaxf(mx, S[reg]);
    mx = fmaxf(mx, __shfl_xor(mx, 32));
    const float mnew = fmaxf(mrun, mx);
    const float alpha = __expf(mrun - mnew);
    float ps = 0.f;
#pragma unroll
    for (int reg = 0; reg < 16; ++reg) { S[reg] = __expf(S[reg] - mnew); ps += S[reg]; }
    lrun = lrun * alpha + ps;
    mrun = mnew;
#pragma unroll
    for (int q = 0; q < 16; ++q) { O0[q] *= alpha; O1[q] *= alpha; }
#pragma unroll
    for (int s2 = 0; s2 < 2; ++s2) {
      union { s16x8 v; unsigned u[4]; } pf;
#pragma unroll
      for (int q = 0; q < 4; ++q) pf.u[q] = pack2(S[8 * s2 + 2 * q], S[8 * s2 + 2 * q + 1]);
      O0 = MFMA(v0[s2].v, pf.v, O0);
      O1 = MFMA(v1[s2].v, pf.v, O1);
    }
#pragma unroll
    for (int ks = 0; ks < 4; ++ks) kf[ks] = kn[ks];
  }
  float lt = lrun + __shfl_xor(lrun, 32);
  if (has_sink) lt += __expf(sink - mrun);
  const float inv = 1.f / lt;
  u16* yo = Yout + (size_t)r * 512;
#pragma unroll
  for (int g4 = 0; g4 < 4; ++g4) {
    *(uint2*)(yo + 8 * g4 + 4 * h) = make_uint2(pack2(O0[4 * g4] * inv, O0[4 * g4 + 1] * inv), pack2(O0[4 * g4 + 2] * inv, O0[4 * g4 + 3] * inv));
    *(uint2*)(yo + 32 + 8 * g4 + 4 * h) = make_uint2(pack2(O1[4 * g4] * inv, O1[4 * g4 + 1] * inv), pack2(O1[4 * g4 + 2] * inv, O1[4 * g4 + 3] * inv));
  }
}

constexpr int AT_BUF = 8192 + 64 * 136;
DI void attn_stage_k(const u16* __restrict__ K, int kb, char* buf, int tid) {
#pragma unroll
  for (int i = 0; i < 2; ++i) {
    const int S = tid + NTHR * i, row = S >> 3, c = (S & 7) ^ ((row >> 1) & 7);
    __builtin_amdgcn_global_load_lds((const unsigned*)(K + (size_t)(kb + row) * 64 + c * 8), (__attribute__((address_space(3))) unsigned*)(buf + S * 16), 16, 0, 0);
  }
}
template <int MODE>
DI void attn_block(const u16* __restrict__ Q, const u16* __restrict__ K, const u16* __restrict__ Vt, u16* __restrict__ Yout,
                   int qpos0, int blk_lo, int blk_n, int w_lo, const float* rpb, float sink, bool has_sink, char* lds) {
  const int tid = TIDX, lane = tid & 63, r = lane & 31, h = lane >> 5;
  s16x8 qf[4];
#pragma unroll
  for (int ks = 0; ks < 4; ++ks) qf[ks] = *(const s16x8*)(Q + r * 64 + ks * 16 + h * 8);
  f32x16 O0, O1;
#pragma unroll
  for (int i = 0; i < 16; ++i) { O0[i] = 0.f; O1[i] = 0.f; }
  float mrun = -INFINITY, lrun = 0.f;
  const int nloc = MODE == 0 ? (blk_n + 1) >> 1 : (MODE == 1 ? blk_n : 0);
  const int nst = 4 + nloc;
  auto step_kb = [&](int st) -> int {
    if (st < 4) return 2048 + st * 64;
    return MODE == 0 ? blk_lo + 64 * (st - 4) : (blk_lo + (st - 4)) * 64;
  };
  typedef __attribute__((ext_vector_type(4))) unsigned u32x4;
  const int vd = tid >> 3, vc = (tid & 7) * 8;
  const int kwofs = vd * 128 + (((tid & 7) ^ ((vd >> 1) & 7)) << 4);
  u32x4 kp[2], vp[2], kq[2], vq[2];
  const int sw = (r >> 1) & 7;
  const int qr = qpos0 >> 6, qc = (qpos0 & 63) + r;
#define AT_LOAD(KR, VR, ST) do { const int kb_ = step_kb((ST) < nst ? (ST) : nst - 1); \
    _Pragma("unroll") for (int i = 0; i < 2; ++i) { KR[i] = *(const u32x4*)(K + (size_t)(kb_ + vd + 32 * i) * 64 + vc); \
                                                    VR[i] = *(const u32x4*)(Vt + (size_t)(vd + 32 * i) * 2304 + kb_ + vc); } } while (0)
#define AT_STORE(KR, VR, BUF) do { _Pragma("unroll") for (int i = 0; i < 2; ++i) { *(u32x4*)((BUF) + kwofs + i * 4096) = KR[i]; \
    char* vp_ = (BUF) + 8192 + (vd + 32 * i) * 136 + vc * 2; \
    *(uint2*)vp_ = make_uint2(VR[i][0], VR[i][1]); *(uint2*)(vp_ + 8) = make_uint2(VR[i][2], VR[i][3]); } } while (0)
  auto compute = [&](const int st, const char* cur) {
    const int kb = step_kb(st);
    bool wave_on = true;
    if (MODE == 1 && st >= 4) { const int rr = blk_lo + (st - 4); wave_on = rr >= w_lo && rr < w_lo + 8; }
    if (wave_on) {
#pragma unroll
      for (int th = 0; th < 2; ++th) {
        if (MODE == 0 && st >= 4 && 2 * (st - 4) + th >= blk_n) continue;
        f32x16 S;
#pragma unroll
        for (int q = 0; q < 16; ++q) S[q] = 0.f;
#pragma unroll
        for (int ks = 0; ks < 4; ++ks) {
          const s16x8 kf = *(const s16x8*)(cur + (th * 32 + r) * 128 + (((ks * 2 + h) ^ sw) << 4));
          S = MFMA(kf, qf[ks], S);
        }
        if (st >= 4) {
          if (MODE == 0) {
            const int d0 = (qpos0 + r) - (kb + 32 * th + 4 * h);
#pragma unroll
            for (int reg = 0; reg < 16; ++reg) { const int d = d0 - ((reg & 3) + 8 * (reg >> 2)); if (d > 128 || d < -128) S[reg] = -INFINITY; }
          } else if (MODE == 1) {
            const int rr = blk_lo + (st - 4);
            const float* brow = rpb + (rr - qr + 7) * 160 + 64;
            const int cstart = min(max(qc - 8, 0), 48);
            const int kc0 = 32 * th + 4 * h;
            const float* bp = brow + (kc0 - qc + 15);
            const int rel = kc0 - cstart;
#pragma unroll
            for (int reg = 0; reg < 16; ++reg) {
              const int o = (reg & 3) + 8 * (reg >> 2);
              const bool ok = (unsigned)(rel + o) < 16u;
              const float tb = S[reg] + bp[o];
              S[reg] = ok ? tb : -INFINITY;
            }
          }
        }
        float mx = S[0];
#pragma unroll
        for (int reg = 1; reg < 16; ++reg) mx = fmaxf(mx, S[reg]);
        mx = fmaxf(mx, __shfl_xor(mx, 32));
        const float mnew = fmaxf(mrun, mx);
        const float alpha = __expf(mrun - mnew);
        float ps = 0.f;
#pragma unroll
        for (int reg = 0; reg < 16; ++reg) { S[reg] = __expf(S[reg] - mnew); ps += S[reg]; }
        lrun = lrun * alpha + ps;
        mrun = mnew;
#pragma unroll
        for (int q = 0; q < 16; ++q) { O0[q] *= alpha; O1[q] *= alpha; }
#pragma unroll
        for (int s2 = 0; s2 < 2; ++s2) {
          union { s16x8 v; unsigned u[4]; } pf;
#pragma unroll
          for (int q = 0; q < 4; ++q) pf.u[q] = pack2(S[8 * s2 + 2 * q], S[8 * s2 + 2 * q + 1]);
          union { s16x8 v; uint2 u[2]; } v0, v1;
          const char* vp0 = cur + 8192 + r * 136 + (32 * th + 16 * s2 + 4 * h) * 2;
          const char* vp1 = vp0 + 32 * 136;
          v0.u[0] = *(const uint2*)vp0; v0.u[1] = *(const uint2*)(vp0 + 16);
          v1.u[0] = *(const uint2*)vp1; v1.u[1] = *(const uint2*)(vp1 + 16);
          O0 = MFMA(v0.v, pf.v, O0);
          O1 = MFMA(v1.v, pf.v, O1);
        }
      }
    }
  };
  char* buf0 = lds;
  char* buf1 = lds + AT_BUF;
  AT_LOAD(kp, vp, 0);
  AT_STORE(kp, vp, buf0);
  AT_LOAD(kp, vp, 1);
  __syncthreads();
#pragma unroll 1
  for (int st = 0; st < nst; st += 2) {
    AT_LOAD(kq, vq, st + 2);
    __builtin_amdgcn_sched_barrier(0);
    compute(st, buf0);
    AT_STORE(kp, vp, buf1);
    __syncthreads();
    if (st + 1 < nst) {
      AT_LOAD(kp, vp, st + 3);
      __builtin_amdgcn_sched_barrier(0);
      compute(st + 1, buf1);
      AT_STORE(kq, vq, buf0);
      __syncthreads();
    }
  }
#undef AT_LOAD
#undef AT_STORE
  float lt = lrun + __shfl_xor(lrun, 32);
  if (has_sink) lt += __expf(sink - mrun);
  const float inv = 1.f / lt;
  u16* yo = Yout + (size_t)r * 512;
#pragma unroll
  for (int g4 = 0; g4 < 4; ++g4) {
    *(uint2*)(yo + 8 * g4 + 4 * h) = make_uint2(pack2(O0[4 * g4] * inv, O0[4 * g4 + 1] * inv), pack2(O0[4 * g4 + 2] * inv, O0[4 * g4 + 3] * inv));
    *(uint2*)(yo + 32 + 8 * g4 + 4 * h) = make_uint2(pack2(O1[4 * g4] * inv, O1[4 * g4 + 1] * inv), pack2(O1[4 * g4 + 2] * inv, O1[4 * g4 + 3] * inv));
  }
}

DI void phase_mix(const Params& p, char* wsb, int layer, char* lds) {
  const bool upd = layer < 3;
  const int n_hl = 512, n_swa = 1024, n_na = 1024, n_ca = upd ? 256 : 0, n_hc = upd ? 512 : 0;
  const int total = n_hl + n_swa + n_na + n_ca + n_hc;
  const int wid = TIDX >> 6;
  u16* Y = (u16*)(wsb + OFF_Y);
  const u16* QS = (const u16*)(wsb + OFF_QS);
  const u16* KS = (const u16*)(wsb + OFF_KS);
  const u16* VTS = (const u16*)(wsb + OFF_VTS);
  const u16* QN = (const u16*)(wsb + OFF_QN);
  const u16* KN = (const u16*)(wsb + OFF_KN);
  const u16* VTN = (const u16*)(wsb + OFF_VTN);
  const int nmine = (total - (int)blockIdx.x + (int)gridDim.x - 1) / (int)gridDim.x;
  const bool rev = blockIdx.x >= (gridDim.x >> 1);
#pragma unroll 1
  for (int q = 0; q < nmine; ++q) {
    const int it = (int)blockIdx.x + (rev ? nmine - 1 - q : q) * (int)gridDim.x;
    int t = it;
    __syncthreads();
    if (t < n_hl) { const int ch = (t & 7) * 64 + (t >> 3); REP(9) { __syncthreads(); hyena_item<64>(p, wsb, layer, ch, lds); } continue; }
    t -= n_hl;
    if (t < n_swa) { REP(10) {
      const int b = t >> 7, kvh = (t >> 6) & 1, qt = t & 63, head = kvh * 4 + wid;
      const int q0 = qt * 32;
      const int lo = max(q0 - 128, 0), hi = min(q0 + 128, 2016);
      __syncthreads();
      if (!(ATT_NEW & 1)) attn_wave<0>(QS + ((size_t)(b * 8 + head) * 2304 + q0) * 64, KS + (size_t)(b * 2 + kvh) * 2304 * 64, VTS + (size_t)(b * 2 + kvh) * 64 * 2304,
                   Y + ((size_t)1 * TT + (size_t)b * 2048 + q0) * 512 + head * 64, q0, nullptr, p.swa_sink[layer * 8 + head], true);
      else attn_block<0>(QS + ((size_t)(b * 8 + head) * 2304 + q0) * 64, KS + (size_t)(b * 2 + kvh) * 2304 * 64, VTS + (size_t)(b * 2 + kvh) * 64 * 2304,
                    Y + ((size_t)1 * TT + (size_t)b * 2048 + q0) * 512 + head * 64, q0, lo, ((hi - lo) >> 5) + 1, 0, nullptr, p.swa_sink[layer * 8 + head], true, lds); }
      continue;
    }
    t -= n_swa;
    if (t < n_na) { REP(10) {
      const int b = t >> 7, head = (t >> 4) & 7, rp = t & 15;
      const int row = rp * 2 + (wid >> 1);
      const int q0 = row * 64 + (wid & 1) * 32;
      const int rs0 = min(max(2 * rp - 4, 0), 24), rs1 = min(max(2 * rp + 1 - 4, 0), 24);
      __syncthreads();
      if (!(ATT_NEW & 2)) attn_wave<1>(QN + ((size_t)(b * 8 + head) * 2304 + q0) * 64, KN + (size_t)(b * 8 + head) * 2304 * 64, VTN + (size_t)(b * 8 + head) * 64 * 2304,
                   Y + ((size_t)2 * TT + (size_t)b * 2048 + q0) * 512 + head * 64, q0, (const float*)(wsb + OFF_RPB) + (size_t)(layer * 8 + head) * 15 * 160, 0.f, false);
      else attn_block<1>(QN + ((size_t)(b * 8 + head) * 2304 + q0) * 64, KN + (size_t)(b * 8 + head) * 2304 * 64, VTN + (size_t)(b * 8 + head) * 64 * 2304,
                    Y + ((size_t)2 * TT + (size_t)b * 2048 + q0) * 512 + head * 64, q0, rs0, rs1 - rs0 + 8, min(max(row - 4, 0), 24),
                    (const float*)(wsb + OFF_RPB) + (size_t)(layer * 8 + head) * 15 * 160, 0.f, false, lds); }
      continue;
    }
    t -= n_na;
    if (t < n_ca) {
      const int b = t >> 5, h16 = (t >> 1) & 15, qt = (t & 1) * 4 + wid;
      const int q0 = 2048 + qt * 32;
      if (h16 < 8) {
        const int head = h16, kvh = head >> 2;
        if (!(ATT_NEW & 4)) attn_wave<2>(QS + ((size_t)(b * 8 + head) * 2304 + q0) * 64, KS + (size_t)(b * 2 + kvh) * 2304 * 64, VTS + (size_t)(b * 2 + kvh) * 64 * 2304,
                     Y + ((size_t)1 * TT + (size_t)TL + b * 256 + qt * 32) * 512 + head * 64, 0, nullptr, p.swa_sink[layer * 8 + head], true);
        else attn_block<2>(QS + ((size_t)(b * 8 + head) * 2304 + q0) * 64, KS + (size_t)(b * 2 + kvh) * 2304 * 64, VTS + (size_t)(b * 2 + kvh) * 64 * 2304,
                      Y + ((size_t)1 * TT + (size_t)TL + b * 256 + qt * 32) * 512 + head * 64, 0, 0, 0, 0, nullptr, p.swa_sink[layer * 8 + head], true, lds);
      } else {
        const int head = h16 - 8;
        if (!(ATT_NEW & 4)) attn_wave<2>(QN + ((size_t)(b * 8 + head) * 2304 + q0) * 64, KN + (size_t)(b * 8 + head) * 2304 * 64, VTN + (size_t)(b * 8 + head) * 64 * 2304,
                     Y + ((size_t)2 * TT + (size_t)TL + b * 256 + qt * 32) * 512 + head * 64, 0, nullptr, 0.f, false);
        else attn_block<2>(QN + ((size_t)(b * 8 + head) * 2304 + q0) * 64, KN + (size_t)(b * 8 + head) * 2304 * 64, VTN + (size_t)(b * 8 + head) * 64 * 2304,
                      Y + ((size_t)2 * TT + (size_t)TL + b * 256 + qt * 32) * 512 + head * 64, 0, 0, 0, 0, nullptr, 0.f, false, lds);
      }
      continue;
    }
    t -= n_ca;
    hyena_item<8>(p, wsb, layer, (t & 7) * 64 + (t >> 3), lds);
  }
}

__global__ void __launch_bounds__(NTHR, 2) fwd_megakernel(Params p0) {
  __shared__ __attribute__((aligned(16))) char lds[65536];
  cg::grid_group grid = cg::this_grid();
  __shared__ uint4 xb_words;
  if (threadIdx.x == 0) xb_words = make_uint4(0u, 0u, 0u, 0u);
  __syncthreads();
  const XcdBarrier xb = xcd_barrier_post((unsigned*)(p0.ws + OFF_BAR), (volatile LAS unsigned*)&xb_words);
  REP(8) { unsigned zo = 0; asm volatile("" : "+s"(zo)); char* wsl = p0.ws + zo; phase_prep(p0, wsl, lds); }
  if (p0.out == nullptr) grid.sync();
  xcd_barrier(xb);
  { unsigned zo = 0; asm volatile("" : "+s"(zo)); char* wsl = p0.ws + zo; phase_mods_reduce(p0, wsl); }
  xcd_barrier(xb);
  for (int layer = 0; layer < 4; ++layer) {
    const bool last = layer == 3;
    const int mr2 = last ? TL : TT;
    REP(4) { unsigned zo = 0; asm volatile("" : "+s"(zo)); char* wsl = p0.ws + zo; phase_norm(p0, wsl, layer, 0, TT, true, lds); }
    REP(5) xcd_barrier(xb);
    REP(1) { unsigned zo = 0; asm volatile("" : "+s"(zo)); char* wsl = p0.ws + zo; phase_gu(p0, wsl, 0, TT, lds); }
    REP(5) xcd_barrier(xb);
    { unsigned zo = 0; asm volatile("" : "+s"(zo)); char* wsl = p0.ws + zo; phase_dn(p0, wsl, layer, 0, TT, false, lds); }
    REP(5) xcd_barrier(xb);
    REP(4) { unsigned zo = 0; asm volatile("" : "+s"(zo)); char* wsl = p0.ws + zo; phase_norm(p0, wsl, layer, 1, TT, false, lds); }
    REP(5) xcd_barrier(xb);
    REP(2) { unsigned zo = 0; asm volatile("" : "+s"(zo)); char* wsl = p0.ws + zo; phase_in(p0, wsl, layer, lds); }
    REP(5) xcd_barrier(xb);
    REP(3) { unsigned zo = 0; asm volatile("" : "+s"(zo)); char* wsl = p0.ws + zo; phase_mix(p0, wsl, layer, lds); }
    REP(5) xcd_barrier(xb);
    REP(7) { unsigned zo = 0; asm volatile("" : "+s"(zo)); char* wsl = p0.ws + zo; phase_m1(p0, wsl, mr2, lds); }
    REP(5) xcd_barrier(xb);
    { unsigned zo = 0; asm volatile("" : "+s"(zo)); char* wsl = p0.ws + zo; phase_m2(p0, wsl, layer, mr2, lds); }
    REP(5) xcd_barrier(xb);
    REP(4) { unsigned zo = 0; asm volatile("" : "+s"(zo)); char* wsl = p0.ws + zo; phase_norm(p0, wsl, layer, 2, mr2, false, lds); }
    REP(5) xcd_barrier(xb);
    REP(1) { unsigned zo = 0; asm volatile("" : "+s"(zo)); char* wsl = p0.ws + zo; phase_gu(p0, wsl, 1, mr2, lds); }
    REP(5) xcd_barrier(xb);
    { unsigned zo = 0; asm volatile("" : "+s"(zo)); char* wsl = p0.ws + zo; phase_dn(p0, wsl, layer, 1, mr2, last, lds); }
    if (!last) { REP(5) xcd_barrier(xb); }
  }
}

extern "C" void kernel_launch(void* const* d_in, const int* in_sizes, int n_in, void* d_out, int out_size, void* d_ws,
                              size_t ws_size, hipStream_t stream) {
  static int grid_blocks = 0;
  if (!grid_blocks) {
    int dev = 0, cus = 0, per_cu = 0;
    hipGetDevice(&dev);
    hipDeviceGetAttribute(&cus, hipDeviceAttributeMultiprocessorCount, dev);
    hipOccupancyMaxActiveBlocksPerMultiprocessor(&per_cu, fwd_megakernel, NTHR, 0);
    if (per_cu > 2) per_cu = 2;
    if (per_cu < 1) per_cu = 1;
    grid_blocks = (cus * per_cu) & ~7;
  }
  if (ws_size < WS_NEED) { fprintf(stderr, "workspace too small: %zu < %zu\n", ws_size, WS_NEED); return; }
  Params p{};
  const float** f = (const float**)&p;
  for (int i = 0; i < 30; ++i) f[i] = (const float*)d_in[i];
  p.out = (float*)d_out;
  p.ws = (char*)d_ws;
  hipMemsetAsync(d_ws, 0, 16384, stream);
  void* args[] = {&p};
  hipError_t e = hipLaunchCooperativeKernel((void*)fwd_megakernel, dim3(grid_blocks), dim3(NTHR), args, 0, stream);
  if (e != hipSuccess) fprintf(stderr, "cooperative launch failed: %s (grid %d)\n", hipGetErrorString(e), grid_blocks);
}
```

```cpp
#include <hip/hip_runtime.h>
#include <hip/hip_cooperative_groups.h>
#include <cstdio>
namespace cg = cooperative_groups;

typedef unsigned short u16;
typedef __attribute__((ext_vector_type(8))) short s16x8;
typedef __attribute__((ext_vector_type(16))) float f32x16;
#define DI __device__ __forceinline__
typedef float f32x4v __attribute__((ext_vector_type(4)));
#define NT_LD4(ptr) __builtin_nontemporal_load((const f32x4v*)(ptr))
#define MFMA(a, b, c) __builtin_amdgcn_mfma_f32_32x32x16_bf16((a), (b), (c), 0, 0, 0)

constexpr int TL = 16384, TC = 2048, TT = 18432;
constexpr int NTHR = 256;
#ifndef PROBE
#define PROBE 0
#endif
#ifndef ATT_NEW
#define ATT_NEW 3
#endif
#define REP(k) for (int rep_ = 0; rep_ < (PROBE == (k) ? 2 : 1); ++rep_)

constexpr size_t OFF_BAR  = 0;
constexpr size_t OFF_MODS = 16384;
constexpr size_t SZ_MODS  = (size_t)4 * 9 * 9216 * 4;
constexpr size_t OFF_MODP = OFF_MODS + SZ_MODS;
constexpr size_t OFF_ROPE = OFF_MODP + 8 * SZ_MODS;
constexpr size_t OFF_RPB  = OFF_ROPE + 16384;
constexpr size_t OFF_FL   = OFF_RPB + 307200;
constexpr size_t OFF_FC   = OFF_FL + (size_t)4 * 4 * 512 * 2048 * 2;
constexpr size_t OFF_XS   = OFF_FC + (size_t)4 * 4 * 512 * 256 * 2;
constexpr size_t OFF_H    = OFF_XS + (size_t)TT * 1024 * 4;
constexpr size_t OFF_Z    = OFF_H + (size_t)TT * 1024 * 2;
constexpr size_t OFF_ZH   = OFF_Z;
constexpr size_t OFF_ZHC  = OFF_ZH + (size_t)8 * 1536 * 2048 * 2;
constexpr size_t OFF_QS   = OFF_ZHC + (size_t)8 * 1536 * 256 * 2;
constexpr size_t OFF_KS   = OFF_QS + (size_t)8 * 8 * 2304 * 64 * 2;
constexpr size_t OFF_VTS  = OFF_KS + (size_t)8 * 2 * 2304 * 64 * 2;
constexpr size_t OFF_QN   = OFF_VTS + (size_t)8 * 2 * 2304 * 64 * 2;
constexpr size_t OFF_KN   = OFF_QN + (size_t)8 * 8 * 2304 * 64 * 2;
constexpr size_t OFF_VTN  = OFF_KN + (size_t)8 * 8 * 2304 * 64 * 2;
constexpr size_t OFF_GATE = OFF_VTN + (size_t)8 * 8 * 2304 * 64 * 2;
constexpr size_t OFF_HID  = OFF_Z;
constexpr size_t OFF_Y    = OFF_GATE + (size_t)TT * 3072 * 2;
constexpr size_t OFF_W    = OFF_Y + (size_t)3 * TT * 512 * 2;
constexpr size_t W_GU0 = 0, W_D0 = 5767168, W_GU1 = 8650752, W_D1 = 14417920, W_IN = 17301504, W_B = 24379392, W_O = 25952256, W_END = 27000832;
constexpr size_t WS_NEED  = OFF_W + W_END * 2;

struct Params {
  const float *x, *c, *ctx, *c_ctx, *w_ada, *b_ada, *norm_g, *ffn_wg, *ffn_wu, *ffn_wd, *w_in,
      *hy_short_w, *hy_short_b, *pe_w0, *pe_b0, *pe_w1, *pe_b1, *pe_w2, *pe_b2, *pe_wout, *sin_freq, *hy_bias,
      *swa_qg, *swa_kg, *swa_sink, *na_qg, *na_kg, *na_rpb, *w_branch, *w_out;
  float* out;
  char* ws;
};

DI int opaque_tid() { int t = threadIdx.x; asm volatile("" : "+v"(t)); return t; }
#define TIDX opaque_tid()
#define GAS __attribute__((address_space(1)))
template <class T>
DI GAS T* uptr(T* p) {
  const unsigned long long v = (unsigned long long)p;
  const unsigned lo = __builtin_amdgcn_readfirstlane((unsigned)v), hi = __builtin_amdgcn_readfirstlane((unsigned)(v >> 32));
  return (GAS T*)(((unsigned long long)hi << 32) | lo);
}
DI int opaque0() { int z = 0; asm volatile("" : "+v"(z)); return z; }
typedef __bf16 bf16x2_t __attribute__((ext_vector_type(2)));
DI u16 f2bf(float x) { return __builtin_bit_cast(u16, (__bf16)x); }
DI float bf2f(u16 v) { return __uint_as_float(((unsigned)v) << 16); }
DI unsigned pack2(float a, float b) { bf16x2_t v = {(__bf16)a, (__bf16)b}; return __builtin_bit_cast(unsigned, v); }
DI int crow(int reg, int h) { return (reg & 3) + 8 * (reg >> 2) + 4 * h; }
DI float sigmoidf_(float x) { return __builtin_amdgcn_rcpf(1.f + __expf(-x)); }

#define XB_TMO      128
#define XB_XCNT(j)  (256  + 64 * (j))
#define XB_XSUB(j)  (1280 + 64 * (j))
#define XB_XGEN(j)  (2304 + 64 * (j))
#define XB_TOP      3328
#define XB_TOPGEN   3392
#define XCD_BAR_WORDS 3456
#define XB_SPIN_CAP (1u << 22)
#define LAS __attribute__((address_space(3)))
DI unsigned xb_ld(unsigned* p) { return __hip_atomic_load(p, __ATOMIC_RELAXED, __HIP_MEMORY_SCOPE_AGENT); }
DI unsigned xb_add(unsigned* p, unsigned v) { return __hip_atomic_fetch_add(p, v, __ATOMIC_RELAXED, __HIP_MEMORY_SCOPE_AGENT); }
DI unsigned xb_xcc_id() { return (unsigned)__builtin_amdgcn_s_getreg((3 << 11) | 20) & 0xFu; }
#define XB_SPIN(cond, bar) do { unsigned _sp = 0; while (cond) { __builtin_amdgcn_s_sleep(1); \
    if ((++_sp & 255u) == 0u) { if (xb_ld(&(bar)[XB_TMO])) break; if (_sp > XB_SPIN_CAP) { atomicAdd(&(bar)[XB_TMO], 1u); break; } } } } while (0)
struct XcdBarrier { unsigned* bar; unsigned x; volatile LAS unsigned* st; };
DI XcdBarrier xcd_barrier_post(unsigned* bar, volatile LAS unsigned* st) {
  XcdBarrier b; b.bar = bar; b.x = xb_xcc_id(); b.st = st;
  if (threadIdx.x == 0) (void)xb_add(&bar[XB_XCNT(b.x)], 1u);
  return b;
}
DI void xcd_barrier_complete(unsigned* bar, unsigned x, unsigned& nloc, unsigned& nx) {
  const unsigned G = gridDim.x;
  unsigned sum, cnt, mine, sp = 0u;
  for (;;) {
    sum = 0u; cnt = 0u; mine = 0u;
#pragma unroll
    for (unsigned j = 0; j < 16; ++j) { const unsigned c = xb_ld(&bar[XB_XCNT(j)]); sum += c; cnt += (c > 0u) ? 1u : 0u; mine = (j == x) ? c : mine; }
    if (sum == G) break;
    __builtin_amdgcn_s_sleep(1);
    if ((++sp & 255u) == 0u) { if (xb_ld(&bar[XB_TMO])) break; if (sp > XB_SPIN_CAP) { atomicAdd(&bar[XB_TMO], 1u); break; } }
  }
  nloc = mine > 0u ? mine : 1u; nx = cnt > 0u ? cnt : 1u;
}
DI void xcd_barrier(const XcdBarrier& b) {
  asm volatile("s_waitcnt vmcnt(0)" ::: "memory");
  __syncthreads();
  if (threadIdx.x == 0) {
    unsigned* bar = b.bar;
    __builtin_amdgcn_s_waitcnt(0);
    unsigned nloc = b.st[0], nx = b.st[1];
    if (nloc == 0u) { xcd_barrier_complete(bar, b.x, nloc, nx); b.st[0] = nloc; b.st[1] = nx; }
    const unsigned old = xb_add(&bar[XB_XSUB(b.x)], 1u);
    const unsigned gen = old / nloc;
    if (old + 1u == (gen + 1u) * nloc) {
      __builtin_amdgcn_fence(__ATOMIC_RELEASE, "agent");
      asm volatile("s_waitcnt vmcnt(0)" ::: "memory");
      const unsigned og = xb_add(&bar[XB_TOP], 1u);
      const unsigned tg = og / nx;
      if (og + 1u == (tg + 1u) * nx) xb_add(&bar[XB_TOPGEN], 1u);
      else XB_SPIN(xb_ld(&bar[XB_TOPGEN]) == tg, bar);
      __builtin_amdgcn_fence(__ATOMIC_ACQUIRE, "agent");
      xb_add(&bar[XB_XGEN(b.x)], 1u);
      asm volatile("s_waitcnt vmcnt(0)" ::: "memory");
    } else {
      XB_SPIN(xb_ld(&bar[XB_XGEN(b.x)]) == gen, bar);
      __builtin_amdgcn_fence(__ATOMIC_ACQUIRE, "agent");
      asm volatile("s_waitcnt vmcnt(0)" ::: "memory");
    }
  }
  __syncthreads();
}

DI void mods_partial(const Params& p, char* wsb, int it, char* lds) {
  const int tid = TIDX;
  const int layer = it / 72, rem = it % 72, cgp = rem >> 3, kc = rem & 7;
  float* s = (float*)lds;
  for (int i = tid; i < 9 * 128; i += NTHR) {
    int r = i >> 7, k = kc * 128 + (i & 127);
    float v = r < 8 ? p.c[r * 1024 + k] : p.c_ctx[k];
    s[i] = v / (1.f + __expf(-v));
  }
  __syncthreads();
  const float* w = p.w_ada + (size_t)layer * 1024 * 9216 + (size_t)(kc * 128) * 9216 + cgp * 1024 + tid * 4;
  float acc[9][4];
#pragma unroll
  for (int r = 0; r < 9; ++r) { acc[r][0] = acc[r][1] = acc[r][2] = acc[r][3] = 0.f; }
#pragma unroll 4
  for (int k = 0; k < 128; ++k) {
    const f32x4v wq = NT_LD4(w + (size_t)k * 9216);
    const float4 wv = make_float4(wq[0], wq[1], wq[2], wq[3]);
#pragma unroll
    for (int r = 0; r < 9; ++r) {
      float sv = s[r * 128 + k];
      acc[r][0] += sv * wv.x; acc[r][1] += sv * wv.y; acc[r][2] += sv * wv.z; acc[r][3] += sv * wv.w;
    }
  }
  float* mp = (float*)(wsb + OFF_MODP);
#pragma unroll
  for (int r = 0; r < 9; ++r) {
    float4 o = make_float4(acc[r][0], acc[r][1], acc[r][2], acc[r][3]);
    *(float4*)(mp + ((size_t)((kc * 4 + layer) * 9 + r)) * 9216 + cgp * 1024 + tid * 4) = o;
  }
  __syncthreads();
}

DI void mlp_layer(const float* in, int in_ld, int nin, float* outp, const float* w, const float* bias, const float* freq) {
  const int tid = TIDX, lag = tid >> 3, fg = tid & 7;
  float a8[8];
#pragma unroll
  for (int q = 0; q < 8; ++q) a8[q] = bias[fg * 8 + q];
#pragma unroll 2
  for (int e = 0; e < nin; ++e) {
    float zv = in[lag * in_ld + e];
#pragma unroll
    for (int q = 0; q < 8; ++q) a8[q] += zv * w[e * 64 + fg * 8 + q];
  }
#pragma unroll
  for (int q = 0; q < 8; ++q) outp[lag * 64 + fg * 8 + q] = sinf(freq[fg * 8 + q] * a8[q]);
}

DI void filter_item(const Params& p, char* wsb, int it, char* lds) {
  const int tid = TIDX;
  const int layer = it / 72, ch = it % 72;
  const bool lat = ch < 64;
  const int L = lat ? 2048 : 256;
  const int l0 = lat ? ch * 32 : (ch - 64) * 32;
  float* zs = (float*)lds;
  float* a0 = zs + 32 * 34;
  float* a1 = a0 + 2048;
  {
    int lag = tid >> 3, j = tid & 7, l = l0 + lag;
    float wl = (6.283185307179586f / (float)L) * (float)l;
#pragma unroll
    for (int q = 0; q < 2; ++q) {
      int e = 2 * j + q;
      float f = 1e-4f + (float)e * ((15.f - 1e-4f) / 15.f);
      zs[lag * 34 + 1 + e] = cosf(f * wl);
      zs[lag * 34 + 17 + e] = -sinf(f * wl);
    }
    if (j == 0) zs[lag * 34] = (float)l / (float)(L - 1);
  }
  __syncthreads();
  const float* freq = p.sin_freq + layer * 64;
  mlp_layer(zs, 34, 33, a0, p.pe_w0 + layer * 33 * 64, p.pe_b0 + layer * 64, freq);
  __syncthreads();
  mlp_layer(a0, 64, 64, a1, p.pe_w1 + layer * 64 * 64, p.pe_b1 + layer * 64, freq);
  __syncthreads();
  mlp_layer(a1, 64, 64, a0, p.pe_w2 + layer * 64 * 64, p.pe_b2 + layer * 64, freq);
  __syncthreads();
  const int col0 = tid * 8, os = col0 >> 9, c0 = col0 & 511;
  const float* wout = p.pe_wout + (size_t)layer * 64 * 2048 + col0;
  u16* dstb = lat ? (u16*)(wsb + OFF_FL) + ((size_t)(layer * 4 + os) * 512 + c0) * 2048
                  : (u16*)(wsb + OFF_FC) + ((size_t)(layer * 4 + os) * 512 + c0) * 256;
  const float mind = -3.0701134573253946f, maxd = -15.350567286626973f;
#pragma unroll 1
  for (int g = 0; g < 8; ++g) {
    float acc[4][8];
#pragma unroll
    for (int a = 0; a < 4; ++a)
#pragma unroll
      for (int b = 0; b < 8; ++b) acc[a][b] = 0.f;
#pragma unroll 2
    for (int f = 0; f < 64; ++f) {
      float4 w0 = *(const float4*)(wout + (size_t)f * 2048), w1 = *(const float4*)(wout + (size_t)f * 2048 + 4);
      float wv[8] = {w0.x, w0.y, w0.z, w0.w, w1.x, w1.y, w1.z, w1.w};
#pragma unroll
      for (int lg = 0; lg < 4; ++lg) {
        float av = a0[(4 * g + lg) * 64 + f];
#pragma unroll
        for (int cc = 0; cc < 8; ++cc) acc[lg][cc] += av * wv[cc];
      }
    }
#pragma unroll
    for (int cc = 0; cc < 8; ++cc) {
      float delta = fabsf(mind + (maxd - mind) * ((float)(c0 + cc) / 511.f));
      float v[4];
#pragma unroll
      for (int lg = 0; lg < 4; ++lg) {
        float t = (float)(l0 + 4 * g + lg) / (float)(L - 1);
        v[lg] = acc[lg][cc] * __expf(-t * delta);
      }
      *(uint2*)(dstb + (size_t)cc * L + l0 + 4 * g) = make_uint2(pack2(v[0], v[1]), pack2(v[2], v[3]));
    }
  }
  __syncthreads();
}

DI void rope_item(const Params& p, char* wsb) {
  float* rt = (float*)(wsb + OFF_ROPE);
  for (int i = TIDX; i < 96 * 16; i += NTHR) {
    int pos = i >> 4, j = i & 15;
    float inv = 1.f / powf(10000.f, (float)(2 * j) / 32.f);
    if (pos < 32) { float a = (float)pos * inv; rt[pos * 16 + j] = cosf(a); rt[512 + pos * 16 + j] = sinf(a); }
    else { int cpos = pos - 32; float a = (float)cpos * inv; rt[1024 + cpos * 16 + j] = cosf(a); rt[2048 + cpos * 16 + j] = sinf(a); }
  }
  float* rb = (float*)(wsb + OFF_RPB);
  for (int i = TIDX; i < 4 * 8 * 15 * 160; i += NTHR) {
    int row = i / 160, e = i % 160;
    rb[i] = (e >= 64 && e < 95) ? p.na_rpb[row * 31 + e - 64] : 0.f;
  }
}

DI void phase_prep(const Params& p, char* wsb, char* lds) {
  const int nb = gridDim.x, bid = blockIdx.x, tid = TIDX;
  float4* xs = (float4*)(wsb + OFF_XS);
  const float4* xin = (const float4*)p.x;
  const float4* cin = (const float4*)p.ctx;
  const size_t nl = (size_t)TL * 256, nc = (size_t)TC * 256;
  {
    const size_t stride = (size_t)nb * NTHR;
#pragma unroll 8
    for (size_t i = (size_t)bid * NTHR + tid; i < nl; i += stride) { const f32x4v q = NT_LD4(xin + i); xs[i] = make_float4(q[0], q[1], q[2], q[3]); }
#pragma unroll 8
    for (size_t i = (size_t)bid * NTHR + tid; i < nc; i += stride) { const f32x4v q = NT_LD4(cin + i); xs[nl + i] = make_float4(q[0], q[1], q[2], q[3]); }
  }
  for (int it = bid; it < 577; it += nb) {
    if (it < 288) mods_partial(p, wsb, it, lds);
    else if (it < 576) filter_item(p, wsb, it - 288, lds);
    else rope_item(p, wsb);
  }
}

DI void phase_mods_reduce(const Params& p, char* wsb) {
  float* mods = (float*)(wsb + OFF_MODS);
  const float* mp = (const float*)(wsb + OFF_MODP);
  const int n = 4 * 9 * 9216;
  for (int i = blockIdx.x * NTHR + TIDX; i < n; i += gridDim.x * NTHR) {
    int layer = i / (9 * 9216), col = i % 9216;
    float s = p.b_ada[layer * 9216 + col];
#pragma unroll
    for (int k = 0; k < 8; ++k) s += mp[(size_t)k * n + i];
    mods[i] = s;
  }
}

DI void convert_tile(const float* __restrict__ src, int N, u16* __restrict__ dst, int K, int k0, int n0, int mode, float* t) {
  const int tid = TIDX;
#pragma unroll
  for (int i = 0; i < 4; ++i) {
    int q = tid + NTHR * i, kr = q >> 4, nc = (q & 15) * 4;
    const f32x4v v = NT_LD4(src + (size_t)(k0 + kr) * N + n0 + nc);
    t[kr * 65 + nc] = v[0]; t[kr * 65 + nc + 1] = v[1]; t[kr * 65 + nc + 2] = v[2]; t[kr * 65 + nc + 3] = v[3];
  }
  __syncthreads();
#pragma unroll
  for (int i = 0; i < 2; ++i) {
    int q = tid + NTHR * i, nr = q >> 3, kc = (q & 7) * 8;
    float v[8];
#pragma unroll
    for (int e = 0; e < 8; ++e) v[e] = t[(kc + e) * 65 + nr];
    int n = n0 + nr;
    int dn = mode == 0 ? n : (64 * (n >> 5) + (n & 31) + (mode == 2 ? 32 : 0));
    *(uint4*)(dst + (size_t)dn * K + k0 + kc) = make_uint4(pack2(v[0], v[1]), pack2(v[2], v[3]), pack2(v[4], v[5]), pack2(v[6], v[7]));
  }
  __syncthreads();
}

DI void convert_item(const Params& p, char* wsb, int layer, int it, char* lds) {
  u16* W = (u16*)(wsb + OFF_W);
  const float* src; u16* dst; int K, N, mode = 0, t = it;
  if (t < 4224) {
    int f = t / 2112; t %= 2112;
    int which = t / 704; t %= 704;
    size_t base = (size_t)(layer * 2 + f) * 1024 * 2816;
    if (which == 0) { src = p.ffn_wg + base; dst = W + (f ? W_GU1 : W_GU0); K = 1024; N = 2816; mode = 1; }
    else if (which == 1) { src = p.ffn_wu + base; dst = W + (f ? W_GU1 : W_GU0); K = 1024; N = 2816; mode = 2; }
    else { src = p.ffn_wd + base; dst = W + (f ? W_D1 : W_D0); K = 2816; N = 1024; }
  } else if (t < 4224 + 1728) {
    t -= 4224; src = p.w_in + (size_t)layer * 1024 * 6912; dst = W + W_IN; K = 1024; N = 6912;
  } else if (t < 4224 + 1728 + 384) {
    t -= 5952; int j = t / 128; t %= 128;
    src = p.w_branch + (size_t)(layer * 3 + j) * 512 * 1024; dst = W + W_B + (size_t)j * 1024 * 512; K = 512; N = 1024;
  } else {
    t -= 6336; src = p.w_out + (size_t)layer * 1024 * 1024; dst = W + W_O; K = 1024; N = 1024;
  }
  int ktiles = K >> 6;
  int kt = t % ktiles, nt = t / ktiles;
  convert_tile(src, N, dst, K, kt * 64, nt * 64, mode, (float*)lds);
}

DI void phase_norm(const Params& p, char* wsb, int layer, int which, int mrows, bool do_convert, char* lds) {
  const int tid = TIDX, lane = tid & 63, wid = tid >> 6;
  const float* xs = (const float*)(wsb + OFF_XS);
  u16* H = (u16*)(wsb + OFF_H);
  const float* mods = (const float*)(wsb + OFF_MODS) + (size_t)layer * 9 * 9216;
  const float* g = p.norm_g + (layer * 3 + which) * 1024;
  const int nw = gridDim.x * 4;
#pragma unroll 2
  for (int row = blockIdx.x * 4 + wid; row < mrows; row += nw) {
    const float4* xr = (const float4*)(xs + (size_t)row * 1024);
    float4 v[4];
    float ss = 0.f;
#pragma unroll
    for (int i = 0; i < 4; ++i) { v[i] = xr[lane + 64 * i]; ss += v[i].x * v[i].x + v[i].y * v[i].y + v[i].z * v[i].z + v[i].w * v[i].w; }
#pragma unroll
    for (int o = 32; o; o >>= 1) ss += __shfl_xor(ss, o);
    const float r = rsqrtf(ss * (1.f / 1024.f) + 1e-6f);
    const int mr = row < TL ? (row >> 11) : 8;
    const float* sh = mods + (size_t)mr * 9216 + (3 * which) * 1024;
    const float* sc = sh + 1024;
#pragma unroll
    for (int i = 0; i < 4; ++i) {
      int col = (lane + 64 * i) * 4;
      float4 gg = *(const float4*)(g + col), s4 = *(const float4*)(sh + col), c4 = *(const float4*)(sc + col);
      float o0 = v[i].x * r * gg.x * (1.f + c4.x) + s4.x;
      float o1 = v[i].y * r * gg.y * (1.f + c4.y) + s4.y;
      float o2 = v[i].z * r * gg.z * (1.f + c4.z) + s4.z;
      float o3 = v[i].w * r * gg.w * (1.f + c4.w) + s4.w;
      *(uint2*)(H + (size_t)row * 1024 + col) = make_uint2(pack2(o0, o1), pack2(o2, o3));
    }
  }
  if (do_convert) {
    for (int it = blockIdx.x; it < 6592; it += gridDim.x) convert_item(p, wsb, layer, it, lds);
  }
}

template <int AI, int BI>
DI void gemm_stage(const u16* __restrict__ A, int lda, const u16* __restrict__ B, int ldb, char* buf, int tid) {
#pragma unroll
  for (int i = 0; i < 2 * AI; ++i) {
    const int S = tid + NTHR * i, row = S >> 3, c = (S & 7) ^ ((row >> 1) & 7);
    __builtin_amdgcn_global_load_lds((const unsigned*)(A + (size_t)row * lda + c * 8), (__attribute__((address_space(3))) unsigned*)(buf + S * 16), 16, 0, 0);
  }
#pragma unroll
  for (int i = 0; i < 2 * BI; ++i) {
    const int S = tid + NTHR * i, row = S >> 3, c = (S & 7) ^ ((row >> 1) & 7);
    __builtin_amdgcn_global_load_lds((const unsigned*)(B + (size_t)row * ldb + c * 8), (__attribute__((address_space(3))) unsigned*)(buf + 16384 + S * 16), 16, 0, 0);
  }
}

template <int AI, int BI>
DI void gemm_tile(const u16* __restrict__ A, int lda, const u16* __restrict__ B, int ldb, int nk, bool swap,
                  f32x16 (&acc)[AI][BI], char* lds) {
  const int tid = TIDX, lane = tid & 63, wid = tid >> 6;
  gemm_stage<AI, BI>(A, lda, B, ldb, lds, tid);
  asm volatile("s_waitcnt vmcnt(0)" ::: "memory");
  __syncthreads();
  const int wa = wid >> 1, wb = wid & 1, r = lane & 31, h = lane >> 5, sw = (r >> 1) & 7;
  const int offA = (swap ? 16384 : 0) + (wa * 32 * AI + r) * 128;
  const int offB = (swap ? 0 : 16384) + (wb * 32 * BI + r) * 128;
  for (int kt = 0; kt < nk; ++kt) {
    const char* cur = lds + (kt & 1) * 32768;
    if (kt + 1 < nk) gemm_stage<AI, BI>(A + (kt + 1) * 64, lda, B + (kt + 1) * 64, ldb, lds + ((kt + 1) & 1) * 32768, tid);
#pragma unroll
    for (int ks = 0; ks < 4; ++ks) {
      const int co = ((ks * 2 + h) ^ sw) << 4;
      s16x8 fa[AI], fb[BI];
#pragma unroll
      for (int i = 0; i < AI; ++i) fa[i] = *(const s16x8*)(cur + offA + i * 4096 + co);
#pragma unroll
      for (int i = 0; i < BI; ++i) fb[i] = *(const s16x8*)(cur + offB + i * 4096 + co);
#pragma unroll
      for (int i = 0; i < AI; ++i)
#pragma unroll
        for (int j = 0; j < BI; ++j) acc[i][j] = MFMA(fa[i], fb[j], acc[i][j]);
    }
    asm volatile("s_waitcnt vmcnt(0)" ::: "memory");
    __syncthreads();
  }
}

template <int AI, int BI>
DI void zero_acc(f32x16 (&acc)[AI][BI]) {
#pragma unroll
  for (int a = 0; a < AI; ++a)
#pragma unroll
    for (int b = 0; b < BI; ++b)
#pragma unroll
      for (int i = 0; i < 16; ++i) acc[a][b][i] = 0.f;
}

DI void gemm_stage_w(const u16* __restrict__ A, int lda, const u16* __restrict__ B, int ldb, char* buf, int tid) {
#pragma unroll
  for (int i = 0; i < 2; ++i) {
    const int S = tid + NTHR * i, row = S >> 2, c = (S & 3) ^ ((row >> 2) & 3);
    __builtin_amdgcn_global_load_lds((const unsigned*)(A + (size_t)row * lda + c * 8), (__attribute__((address_space(3))) unsigned*)(buf + S * 16), 16, 0, 0);
  }
#pragma unroll
  for (int i = 0; i < 4; ++i) {
    const int S = tid + NTHR * i, row = S >> 2, c = (S & 3) ^ ((row >> 2) & 3);
    __builtin_amdgcn_global_load_lds((const unsigned*)(B + (size_t)row * ldb + c * 8), (__attribute__((address_space(3))) unsigned*)(buf + 8192 + S * 16), 16, 0, 0);
  }
}
DI void gemm_tile_w(const u16* __restrict__ A, int lda, const u16* __restrict__ B, int ldb, int nk, bool swap,
                    f32x16 (&acc)[2][4], char* lds) {
  const int tid = TIDX, lane = tid & 63, wid = tid >> 6;
  gemm_stage_w(A, lda, B, ldb, lds, tid);
  asm volatile("s_waitcnt vmcnt(0)" ::: "memory");
  __syncthreads();
  const int r = lane & 31, h = lane >> 5, sw = (r >> 2) & 3;
  const int wa = swap ? wid : (wid >> 1), wb = swap ? 0 : (wid & 1);
  const int offF = (swap ? 8192 : 0) + (wa * 64 + r) * 64;
  const int offS = (swap ? 0 : 8192) + (wb * 128 + r) * 64;
  for (int kt = 0; kt < nk; ++kt) {
    const char* cur = lds + (kt & 1) * 24576;
    if (kt + 1 < nk) gemm_stage_w(A + (kt + 1) * 32, lda, B + (kt + 1) * 32, ldb, lds + ((kt + 1) & 1) * 24576, tid);
#pragma unroll
    for (int ks = 0; ks < 2; ++ks) {
      const int co = ((ks * 2 + h) ^ sw) << 4;
      s16x8 f0 = *(const s16x8*)(cur + offF + co), f1 = *(const s16x8*)(cur + offF + 2048 + co);
#pragma unroll
      for (int si = 0; si < 4; ++si) {
        s16x8 sb = *(const s16x8*)(cur + offS + si * 2048 + co);
        acc[0][si] = MFMA(f0, sb, acc[0][si]);
        acc[1][si] = MFMA(f1, sb, acc[1][si]);
      }
    }
    asm volatile("s_waitcnt vmcnt(0)" ::: "memory");
    __syncthreads();
  }
}
DI void zero_acc_w(f32x16 (&acc)[2][4]) {
#pragma unroll
  for (int a = 0; a < 2; ++a)
#pragma unroll
    for (int b = 0; b < 4; ++b)
#pragma unroll
      for (int i = 0; i < 16; ++i) acc[a][b][i] = 0.f;
}

DI bool next_tile(int rnd, int MT, int NT, int& mt, int& nt) {
  const int G8 = gridDim.x >> 3, x = blockIdx.x & 7, slot = blockIdx.x >> 3;
  const int T = (rnd * 8 + x) * G8 + slot;
  if (T >= MT * NT) return false;
  const int band = T / (NT * 8), rem = T - band * NT * 8;
  nt = rem >> 3; mt = band * 8 + (rem & 7);
  return true;
}

template <int AI>
DI void gu_tile(char* wsb, int sub, int m0, int n0, char* lds) {
  const u16* H = (const u16*)(wsb + OFF_H);
  const u16* W = (const u16*)(wsb + OFF_W) + (sub ? W_GU1 : W_GU0);
  u16* HID = (u16*)(wsb + OFF_HID);
  const int lane = TIDX & 63, wid = TIDX >> 6, wa = wid >> 1, wb = wid & 1, r = lane & 31, h = lane >> 5;
  f32x16 acc[AI][2]; zero_acc<AI, 2>(acc);
  gemm_tile<AI, 2>(H + (size_t)m0 * 1024, 1024, W + (size_t)n0 * 1024, 1024, 16, false, acc, lds);
  const int m0e = m0 + opaque0();
  const int hc = (n0 >> 1) + wb * 32 + r;
  GAS u16* HIDu = uptr(HID);
  const unsigned ib = (unsigned)((m0e + wa * 32 * AI + 4 * h) * 2816 + hc);
#pragma unroll
  for (int ai = 0; ai < AI; ++ai)
#pragma unroll
    for (int reg = 0; reg < 16; ++reg) {
      float g = acc[ai][0][reg], u = acc[ai][1][reg];
      float v = g * __builtin_amdgcn_rcpf(1.f + __expf(-g)) * u;
      HIDu[ib + (unsigned)((ai * 32 + (reg & 3) + 8 * (reg >> 2)) * 2816)] = f2bf(v);
      if ((reg & 7) == 7) __builtin_amdgcn_sched_barrier(0);
    }
}
DI void phase_gu(const Params& p, char* wsb, int sub, int mrows, char* lds) {
  int mt, nt;
  for (int rnd = 0; next_tile(rnd, 128, 44, mt, nt); ++rnd) gu_tile<2>(wsb, sub, mt * 128, nt * 128, lds);
  if (mrows > TL)
    for (int rnd = 0; next_tile(rnd, 32, 44, mt, nt); ++rnd) gu_tile<1>(wsb, sub, TL + mt * 64, nt * 128, lds);
}

template <int AI, int BI>
DI void dn_tile(const Params& p, char* wsb, int layer, int sub, bool final_out, int m0, int n0, char* lds) {
  const u16* HID = (const u16*)(wsb + OFF_HID);
  const u16* W = (const u16*)(wsb + OFF_W) + (sub ? W_D1 : W_D0);
  float* xs = (float*)(wsb + OFF_XS);
  const float* mods = (const float*)(wsb + OFF_MODS) + (size_t)layer * 9 * 9216;
  const int lane = TIDX & 63, wid = TIDX >> 6, wa = wid >> 1, wb = wid & 1, r = lane & 31, h = lane >> 5;
  f32x16 acc[AI][BI]; zero_acc<AI, BI>(acc);
  gemm_tile<AI, BI>(HID + (size_t)m0 * 2816, 2816, W + (size_t)n0 * 2816, 2816, 44, false, acc, lds);
  const int m0e = m0 + opaque0();
  const int mr = m0 < TL ? (m0 >> 11) : 8;
  const float* gate = mods + (size_t)mr * 9216 + (2 + 6 * sub) * 1024;
  GAS float* xsu = uptr(xs);
  GAS float* outu = uptr(p.out);
#pragma unroll
  for (int bi = 0; bi < BI; ++bi) {
    const int n = n0 + wb * 32 * BI + bi * 32 + r;
    const float gv = 0.5f * gate[n];
    const unsigned ib = (unsigned)((m0e + wa * 32 * AI + 4 * h) * 1024 + n);
#pragma unroll
    for (int ai = 0; ai < AI; ++ai)
#pragma unroll
      for (int reg = 0; reg < 16; ++reg) {
        const unsigned idx = ib + (unsigned)((ai * 32 + (reg & 3) + 8 * (reg >> 2)) * 1024);
        float v = xsu[idx] + gv * acc[ai][bi][reg];
        if (final_out) outu[idx] = v; else xsu[idx] = v;
        if ((reg & 7) == 7) __builtin_amdgcn_sched_barrier(0);
      }
  }
}
DI void phase_dn(const Params& p, char* wsb, int layer, int sub, int mrows, bool final_out, char* lds) {
  int mt, nt;
  for (int rnd = 0; next_tile(rnd, 128, 8, mt, nt); ++rnd) dn_tile<2, 2>(p, wsb, layer, sub, final_out, mt * 128, nt * 128, lds);
  if (mrows > TL)
    for (int rnd = 0; next_tile(rnd, 32, 16, mt, nt); ++rnd) dn_tile<1, 1>(p, wsb, layer, sub, final_out, TL + mt * 64, nt * 64, lds);
}

DI void phase_in(const Params& p, char* wsb, int layer, char* lds) {
  const u16* H = (const u16*)(wsb + OFF_H);
  const u16* W = (const u16*)(wsb + OFF_W) + W_IN;
  const float* rope = (const float*)(wsb + OFF_ROPE);
  const int lane = TIDX & 63, wid = TIDX >> 6, wa = wid >> 1, wb = wid & 1, r = lane & 31, h = lane >> 5;
  int mt, nt;
  for (int rnd = 0; next_tile(rnd, 144, 54, mt, nt); ++rnd) {
    const int m0 = mt * 128, n0 = nt * 128;
    if (layer == 3 && m0 >= TL && !(n0 == 2048 || n0 == 2176 || (n0 >= 2816 && n0 < 3840))) continue;
    const bool swap = n0 < 3840;
    f32x16 acc[2][2]; zero_acc<2, 2>(acc);
    gemm_tile<2, 2>(H + (size_t)m0 * 1024, 1024, W + (size_t)n0 * 1024, 1024, 16, swap, acc, lds);
    const int m0e = m0 + opaque0();
    if (!swap) {
      GAS u16* G = uptr((u16*)(wsb + OFF_GATE));
#pragma unroll
      for (int bi = 0; bi < 2; ++bi) {
        const int n = n0 - 3840 + wb * 64 + bi * 32 + r;
        const unsigned ib = (unsigned)((m0e + wa * 64 + 4 * h) * 3072 + n);
#pragma unroll
        for (int ai = 0; ai < 2; ++ai)
#pragma unroll
          for (int reg = 0; reg < 16; ++reg)
            G[ib + (unsigned)((ai * 32 + (reg & 3) + 8 * (reg >> 2)) * 3072)] = f2bf(sigmoidf_(acc[ai][bi][reg]));
      }
      continue;
    }
    const bool isctx = m0 >= TL;
    if (n0 < 1536) {
#pragma unroll
      for (int bi = 0; bi < 2; ++bi) {
        const int m = m0e + wb * 64 + bi * 32 + r;
        u16* dst; size_t tstride;
        if (!isctx) { int b = m >> 11, t = m & 2047; dst = (u16*)(wsb + OFF_ZH) + (size_t)b * 1536 * 2048 + t; tstride = 2048; }
        else { int mm = m - TL; int b = mm >> 8, t = mm & 255; dst = (u16*)(wsb + OFF_ZHC) + (size_t)b * 1536 * 256 + t; tstride = 256; }
#pragma unroll
        for (int ai = 0; ai < 2; ++ai)
#pragma unroll
          for (int reg = 0; reg < 16; ++reg) {
            int n = n0 + wa * 64 + ai * 32 + crow(reg, h);
            dst[(size_t)n * tstride] = f2bf(acc[ai][bi][reg]);
          }
      }
      continue;
    }
    int kind, head;
    bool na;
    {
      int nn = n0 + wa * 64;
      if (nn < 2304) { na = false; int o = nn - 1536; if (o < 512) { kind = 0; head = o >> 6; } else if (o < 640) { kind = 1; head = (o - 512) >> 6; } else { kind = 2; head = (o - 640) >> 6; } }
      else { na = true; int o = nn - 2304; kind = o >> 9; head = (o & 511) >> 6; }
    }
    const int nheads = (!na && kind != 0) ? 2 : 8;
#pragma unroll
    for (int bi = 0; bi < 2; ++bi) {
      const int m = m0e + wb * 64 + bi * 32 + r;
      int b, tok, pos;
      if (!isctx) { b = m >> 11; pos = m & 2047; tok = pos; } else { int mm = m - TL; b = mm >> 8; pos = 0; tok = 2048 + (mm & 255); }
      if (kind == 2) {
        u16* dst = (u16*)(wsb + (na ? OFF_VTN : OFF_VTS)) + ((size_t)(b * nheads + head) * 64) * 2304 + tok;
#pragma unroll
        for (int ai = 0; ai < 2; ++ai)
#pragma unroll
          for (int reg = 0; reg < 16; ++reg) {
            int d = ai * 32 + crow(reg, h);
            dst[(size_t)d * 2304] = f2bf(acc[ai][bi][reg]);
          }
      } else {
        const float* gain = (na ? (kind == 0 ? p.na_qg : p.na_kg) : (kind == 0 ? p.swa_qg : p.swa_kg)) + layer * 64;
        float ss = 0.f;
#pragma unroll
        for (int ai = 0; ai < 2; ++ai)
#pragma unroll
          for (int reg = 0; reg < 16; ++reg) ss += acc[ai][bi][reg] * acc[ai][bi][reg];
        ss += __shfl_xor(ss, 32);
        const float rn = rsqrtf(ss * (1.f / 64.f) + 1e-6f);
        float v[2][16];
#pragma unroll
        for (int ai = 0; ai < 2; ++ai)
#pragma unroll
          for (int reg = 0; reg < 16; ++reg) v[ai][reg] = acc[ai][bi][reg] * rn * gain[ai * 32 + crow(reg, h)];
        if (!na && !isctx) {
          const int prow = pos >> 6, pcol = pos & 63;
#pragma unroll
          for (int ai = 0; ai < 2; ++ai) {
            const float* ct = ai == 0 ? rope + prow * 16 : rope + 1024 + pcol * 16;
            const float* st = ai == 0 ? rope + 512 + prow * 16 : rope + 2048 + pcol * 16;
#pragma unroll
            for (int reg = 0; reg < 8; ++reg) {
              int j = crow(reg, h);
              float cs = ct[j], sn = st[j];
              float x1 = v[ai][reg], x2 = v[ai][reg + 8];
              v[ai][reg] = x1 * cs - x2 * sn;
              v[ai][reg + 8] = x2 * cs + x1 * sn;
            }
          }
        }
        const float qs = kind == 0 ? 0.125f : 1.f;
        u16* dst = (u16*)(wsb + (na ? (kind == 0 ? OFF_QN : OFF_KN) : (kind == 0 ? OFF_QS : OFF_KS))) +
                   ((size_t)(b * nheads + head) * 2304 + tok) * 64;
#pragma unroll
        for (int ai = 0; ai < 2; ++ai)
#pragma unroll
          for (int g4 = 0; g4 < 4; ++g4) {
            int d0 = ai * 32 + 8 * g4 + 4 * h;
            *(uint2*)(dst + d0) = make_uint2(pack2(v[ai][4 * g4] * qs, v[ai][4 * g4 + 1] * qs), pack2(v[ai][4 * g4 + 2] * qs, v[ai][4 * g4 + 3] * qs));
          }
      }
    }
  }
}

template <int AI, int BI>
DI void m1_tile(char* wsb, int m0, int n0, char* lds) {
  const u16* Y = (const u16*)(wsb + OFF_Y);
  const u16* W = (const u16*)(wsb + OFF_W) + W_B;
  const u16* G = (const u16*)(wsb + OFF_GATE);
  u16* GM = (u16*)(wsb + OFF_H);
  const int tid = TIDX, lane = tid & 63, wid = tid >> 6, wa = wid >> 1, wb = wid & 1, r = lane & 31, h = lane >> 5, sw = (r >> 1) & 7;
  f32x16 tot[AI][BI], acc[AI][BI];
  zero_acc<AI, BI>(tot); zero_acc<AI, BI>(acc);
  const u16* Wt = W + (size_t)n0 * 512;
  const u16* Yt = Y + (size_t)m0 * 512;
  gemm_stage<AI, BI>(Wt, 512, Yt, 512, lds, tid);
  asm volatile("s_waitcnt vmcnt(0)" ::: "memory");
  __syncthreads();
  const int offA = (wa * 32 * AI + r) * 128;
  const int offB = 16384 + (wb * 32 * BI + r) * 128;
  uint2 gq[AI][BI][4];
#pragma unroll 1
  for (int kt = 0; kt < 24; ++kt) {
    const char* cur = lds + (kt & 1) * 32768;
    const int j = kt >> 3, kk = kt & 7;
    if (kt + 1 < 24) {
      const int j1 = (kt + 1) >> 3, k1 = (kt + 1) & 7;
      gemm_stage<AI, BI>(Wt + (size_t)j1 * 1024 * 512 + k1 * 64, 512, Yt + (size_t)j1 * TT * 512 + k1 * 64, 512, lds + ((kt + 1) & 1) * 32768, tid);
    }
    if (kk == 0) {
#pragma unroll
      for (int bi = 0; bi < BI; ++bi) {
        const size_t m = (size_t)(m0 + wb * 32 * BI + bi * 32 + r);
#pragma unroll
        for (int ai = 0; ai < AI; ++ai)
#pragma unroll
          for (int g4 = 0; g4 < 4; ++g4)
            gq[ai][bi][g4] = *(const uint2*)(G + m * 3072 + j * 1024 + n0 + wa * 32 * AI + ai * 32 + 8 * g4 + 4 * h);
      }
    }
#pragma unroll
    for (int ks = 0; ks < 4; ++ks) {
      const int co = ((ks * 2 + h) ^ sw) << 4;
      s16x8 fa[AI], fb[BI];
#pragma unroll
      for (int i = 0; i < AI; ++i) fa[i] = *(const s16x8*)(cur + offA + i * 4096 + co);
#pragma unroll
      for (int i = 0; i < BI; ++i) fb[i] = *(const s16x8*)(cur + offB + i * 4096 + co);
#pragma unroll
      for (int i = 0; i < AI; ++i)
#pragma unroll
        for (int jj = 0; jj < BI; ++jj) acc[i][jj] = MFMA(fa[i], fb[jj], acc[i][jj]);
    }
    if (kk == 7) {
#pragma unroll
      for (int ai = 0; ai < AI; ++ai)
#pragma unroll
        for (int bi = 0; bi < BI; ++bi)
#pragma unroll
          for (int g4 = 0; g4 < 4; ++g4) {
            const uint2 gv = gq[ai][bi][g4];
            tot[ai][bi][4 * g4 + 0] += bf2f((u16)(gv.x & 0xffff)) * acc[ai][bi][4 * g4 + 0];
            tot[ai][bi][4 * g4 + 1] += bf2f((u16)(gv.x >> 16)) * acc[ai][bi][4 * g4 + 1];
            tot[ai][bi][4 * g4 + 2] += bf2f((u16)(gv.y & 0xffff)) * acc[ai][bi][4 * g4 + 2];
            tot[ai][bi][4 * g4 + 3] += bf2f((u16)(gv.y >> 16)) * acc[ai][bi][4 * g4 + 3];
          }
      zero_acc<AI, BI>(acc);
    }
    asm volatile("s_waitcnt vmcnt(0)" ::: "memory");
    __syncthreads();
  }
  const int m0f = m0 + opaque0();
#pragma unroll
  for (int bi = 0; bi < BI; ++bi) {
    const size_t m = (size_t)(m0f + wb * 32 * BI + bi * 32 + r);
#pragma unroll
    for (int ai = 0; ai < AI; ++ai)
#pragma unroll
      for (int g4 = 0; g4 < 4; ++g4)
        *(uint2*)(GM + m * 1024 + n0 + wa * 32 * AI + ai * 32 + 8 * g4 + 4 * h) =
            make_uint2(pack2(tot[ai][bi][4 * g4], tot[ai][bi][4 * g4 + 1]), pack2(tot[ai][bi][4 * g4 + 2], tot[ai][bi][4 * g4 + 3]));
  }
}
DI void phase_m1(const Params& p, char* wsb, int mrows, char* lds) {
  int mt, nt;
  for (int rnd = 0; next_tile(rnd, 128, 8, mt, nt); ++rnd) m1_tile<2, 2>(wsb, mt * 128, nt * 128, lds);
  if (mrows > TL)
    for (int rnd = 0; next_tile(rnd, 32, 16, mt, nt); ++rnd) m1_tile<1, 1>(wsb, TL + mt * 64, nt * 64, lds);
}

template <int AI, int BI>
DI void m2_tile(char* wsb, int layer, int m0, int n0, char* lds) {
  const u16* GM = (const u16*)(wsb + OFF_H);
  const u16* W = (const u16*)(wsb + OFF_W) + W_O;
  float* xs = (float*)(wsb + OFF_XS);
  const float* mods = (const float*)(wsb + OFF_MODS) + (size_t)layer * 9 * 9216;
  const int lane = TIDX & 63, wid = TIDX >> 6, wa = wid >> 1, wb = wid & 1, r = lane & 31, h = lane >> 5;
  f32x16 acc[AI][BI]; zero_acc<AI, BI>(acc);
  gemm_tile<AI, BI>(GM + (size_t)m0 * 1024, 1024, W + (size_t)n0 * 1024, 1024, 16, false, acc, lds);
  const int m0e = m0 + opaque0();
  const int mr = m0 < TL ? (m0 >> 11) : 8;
  const float* gate = mods + (size_t)mr * 9216 + 5 * 1024;
  GAS float* xsu = uptr(xs);
#pragma unroll
  for (int bi = 0; bi < BI; ++bi) {
    const int n = n0 + wb * 32 * BI + bi * 32 + r;
    const float gv = gate[n];
    const unsigned ib = (unsigned)((m0e + wa * 32 * AI + 4 * h) * 1024 + n);
#pragma unroll
    for (int ai = 0; ai < AI; ++ai)
#pragma unroll
      for (int reg = 0; reg < 16; ++reg) {
        const unsigned idx = ib + (unsigned)((ai * 32 + (reg & 3) + 8 * (reg >> 2)) * 1024);
        xsu[idx] += gv * acc[ai][bi][reg];
        if ((reg & 7) == 7) __builtin_amdgcn_sched_barrier(0);
      }
  }
}
DI void phase_m2(const Params& p, char* wsb, int layer, int mrows, char* lds) {
  int mt, nt;
  for (int rnd = 0; next_tile(rnd, 128, 8, mt, nt); ++rnd) m2_tile<2, 2>(wsb, layer, mt * 128, nt * 128, lds);
  if (mrows > TL)
    for (int rnd = 0; next_tile(rnd, 32, 16, mt, nt); ++rnd) m2_tile<1, 1>(wsb, layer, TL + mt * 64, nt * 64, lds);
}

DI float sconv(const u16* z, int t, int L, float w0, float w1, float w2, float bb) {
  float zm = t > 0 ? bf2f(z[t - 1]) : 0.f, z0 = bf2f(z[t]), zp = t + 1 < L ? bf2f(z[t + 1]) : 0.f;
  return w0 * zm + w1 * z0 + w2 * zp + bb;
}

template <int NB1>
DI void hyena_item(const Params& p, char* wsb, int layer, int c, char* lds) {
  constexpr int L = NB1 * 32;
  constexpr int TPW = NB1 == 64 ? 4 : 1;
  const int tid = TIDX, lane = tid & 63, wid = tid >> 6, r = lane & 31, h = lane >> 5;
  u16* U = (u16*)lds;
  u16* R = (u16*)(lds + 40960);
  const u16* zbase = NB1 == 64 ? (const u16*)(wsb + OFF_ZH) : (const u16*)(wsb + OFF_ZHC);
  const float* sw = p.hy_short_w + layer * 3 * 1536;
  const float* sb = p.hy_short_b + layer * 1536;
  {
    const float w0 = sw[c], w1 = sw[1536 + c], w2 = sw[3072 + c], bb = sb[c];
#pragma unroll 2
    for (int ch = tid; ch < L; ch += NTHR) {
      const int b = ch / (L / 8), t = (ch % (L / 8)) * 8;
      const u16* zr = zbase + ((size_t)(b * 1536 + c)) * L;
      const uint4 zz = *(const uint4*)(zr + t);
      const float zm1 = bf2f(zr[t > 0 ? t - 1 : 0]) * (t > 0 ? 1.f : 0.f);
      const float zp8 = bf2f(zr[t + 8 < L ? t + 8 : L - 1]) * (t + 8 < L ? 1.f : 0.f);
      const unsigned zw[4] = {zz.x, zz.y, zz.z, zz.w};
      float zv[10];
      zv[0] = zm1; zv[9] = zp8;
#pragma unroll
      for (int q = 0; q < 4; ++q) { zv[1 + 2 * q] = bf2f((u16)(zw[q] & 0xffff)); zv[2 + 2 * q] = bf2f((u16)(zw[q] >> 16)); }
      float o[8];
#pragma unroll
      for (int e = 0; e < 8; ++e) o[e] = w0 * zv[e] + w1 * zv[e + 1] + w2 * zv[e + 2] + bb;
      *(uint4*)(U + (b * NB1 + (t >> 5)) * 40 + (t & 31)) = make_uint4(pack2(o[0], o[1]), pack2(o[2], o[3]), pack2(o[4], o[5]), pack2(o[6], o[7]));
    }
  }
  if (NB1 == 64) {
    unsigned acc_t = 0;
#pragma unroll
    for (int q = 0; q < 4; ++q) {
      const int b = 2 * wid + (q & 1), xc = (q >> 1 ? 1024 : 512) + c;
      const unsigned* rowp = (const unsigned*)(zbase + ((size_t)(b * 1536 + xc)) * L);
      acc_t += rowp[(lane & 31) * 32 + (lane >> 5) * 16];
    }
    asm volatile("" ::"v"(acc_t));
  }
  const bool active = NB1 == 64 ? true : (wid < 2);
  const u16* filt = NB1 == 64 ? (const u16*)(wsb + OFF_FL) : (const u16*)(wsb + OFF_FC);
  int tb[TPW], tt1[TPW];
#pragma unroll
  for (int j = 0; j < TPW; ++j) { int col = (wid * TPW + j) * 32 + r; tb[j] = col / NB1; tt1[j] = col % NB1; }
  int ub[TPW];
#pragma unroll
  for (int j = 0; j < TPW; ++j) ub[j] = ((tb[j] * NB1 + tt1[j]) * 40 + 8 * h) * 2;
  const int zaddr = 40960 + 2 * L * 2 + 64;
  const int pbase = (L - 1) - r + 8 * h;
  const unsigned sh = (unsigned)(pbase & 1) << 4;
  const unsigned* Rd = (const unsigned*)R + (pbase >> 1);
#pragma unroll 1
  for (int order = 0; order < 2; ++order) {
    __syncthreads();
    {
      const u16* fp = filt + ((size_t)((layer * 4 + order * 2 + 0) * 512 + c)) * L;
      const u16* fn = filt + ((size_t)((layer * 4 + order * 2 + 1) * 512 + c)) * L;
      for (int ch = tid; ch < (2 * L + 64) / 8; ch += NTHR) {
        const int i0 = ch * 8;
        uint4 o;
        if (i0 < L) {
          const uint4 v = *(const uint4*)(fp + (L - 8 - i0));
          o.x = (v.w >> 16) | (v.w << 16); o.y = (v.z >> 16) | (v.z << 16); o.z = (v.y >> 16) | (v.y << 16); o.w = (v.x >> 16) | (v.x << 16);
        } else {
          unsigned e8[8];
#pragma unroll
          for (int e = 0; e < 8; ++e) { const int i = i0 + e; e8[e] = i <= 2 * L - 2 ? (unsigned)fn[i - (L - 1)] : 0u; }
          o.x = e8[0] | (e8[1] << 16); o.y = e8[2] | (e8[3] << 16); o.z = e8[4] | (e8[5] << 16); o.w = e8[6] | (e8[7] << 16);
        }
        *(uint4*)(R + i0) = o;
      }
    }
    __syncthreads();
    if (active) {
      const int xcol = (order == 0 ? 512 : 1024) + c;
      const float w0 = sw[xcol], w1 = sw[1536 + xcol], w2 = sw[3072 + xcol], bb = sb[xcol];
      const float bias = p.hy_bias[(layer * 2 + order) * 512 + c];
      f32x16 acc[TPW];
#pragma unroll
      for (int j = 0; j < TPW; ++j)
#pragma unroll
        for (int i = 0; i < 16; ++i) acc[j][i] = 0.f;
      auto d1_range = [&](const int lo, const int hi, const int jmask) {
#pragma unroll 1
        for (int d1o = lo; d1o < hi; d1o += 2) {
#pragma unroll
          for (int dk = 0; dk < 4; ++dk) {
            const int d1 = d1o + (dk >> 1), ks = dk & 1;
            const unsigned* rp = Rd + (-16 * d1 + 8 * ks);
            unsigned w[5];
#pragma unroll
            for (int q = 0; q < 5; ++q) w[q] = rp[q];
            union { s16x8 v; unsigned u[4]; } af;
#pragma unroll
            for (int q = 0; q < 4; ++q) af.u[q] = __builtin_amdgcn_alignbit(w[q + 1], w[q], sh);
#pragma unroll
            for (int j = 0; j < TPW; ++j) {
              if (!((jmask >> (j & 1)) & 1)) continue;
              const bool ok = (unsigned)(tt1[j] - d1) < (unsigned)NB1;
              const int addr = ok ? ub[j] - d1 * 80 + ks * 32 : zaddr;
              const s16x8 bf = *(const s16x8*)(lds + addr);
              acc[j] = MFMA(af.v, bf, acc[j]);
            }
          }
        }
      };
      if (NB1 == 64) { d1_range(-64, -32, 1); d1_range(-32, 32, 3); d1_range(32, 64, 2); }
      else d1_range(-NB1, NB1, 3);
#pragma unroll
      for (int j = 0; j < TPW; ++j) {
        const u16* zr = zbase + ((size_t)(tb[j] * 1536 + xcol)) * L;
#pragma unroll
        for (int g4 = 0; g4 < 4; ++g4) {
          const int t0 = 8 * g4 + 4 * h, t = 32 * tt1[j] + t0;
          const int uidx = (tb[j] * NB1 + tt1[j]) * 40 + t0;
          const uint2 uu = *(const uint2*)(U + uidx);
          const uint2 zz = *(const uint2*)(zr + t);
          const float zm1 = t > 0 ? bf2f(zr[t - 1]) : 0.f;
          const float zp4 = t + 4 < L ? bf2f(zr[t + 4]) : 0.f;
          const float zv[6] = {zm1, bf2f((u16)(zz.x & 0xffff)), bf2f((u16)(zz.x >> 16)), bf2f((u16)(zz.y & 0xffff)), bf2f((u16)(zz.y >> 16)), zp4};
          const float uv[4] = {bf2f((u16)(uu.x & 0xffff)), bf2f((u16)(uu.x >> 16)), bf2f((u16)(uu.y & 0xffff)), bf2f((u16)(uu.y >> 16))};
          float yv[4];
#pragma unroll
          for (int e = 0; e < 4; ++e) {
            const float xv = w0 * zv[e] + w1 * zv[e + 1] + w2 * zv[e + 2] + bb;
            yv[e] = xv * (acc[j][4 * g4 + e] + bias * uv[e]);
          }
          if (order == 0) *(uint2*)(U + uidx) = make_uint2(pack2(yv[0], yv[1]), pack2(yv[2], yv[3]));
          else {
            const size_t row = NB1 == 64 ? (size_t)tb[j] * 2048 + t : (size_t)TL + tb[j] * 256 + t;
            u16* yo = (u16*)(wsb + OFF_Y) + row * 512 + c;
#pragma unroll
            for (int e = 0; e < 4; ++e) yo[(size_t)e * 512] = f2bf(yv[e]);
          }
        }
      }
    }
  }
}

template <int MODE>
DI void attn_wave(const u16* __restrict__ Q, const u16* __restrict__ K, const u16* __restrict__ Vt, u16* __restrict__ Yout,
                  int qpos0, const float* rpb, float sink, bool has_sink) {
  const int lane = TIDX & 63, r = lane & 31, h = lane >> 5;
  s16x8 qf[4];
#pragma unroll
  for (int ks = 0; ks < 4; ++ks) qf[ks] = *(const s16x8*)(Q + r * 64 + ks * 16 + h * 8);
  f32x16 O0, O1;
#pragma unroll
  for (int i = 0; i < 16; ++i) { O0[i] = 0.f; O1[i] = 0.f; }
  float mrun = -INFINITY, lrun = 0.f;
  int nloc = 0, jlo = 0, qr = 0, qc = 0, rs = 0;
  if (MODE == 0) {
    jlo = qpos0 < 128 ? (128 - qpos0) >> 5 : 0;
    const int jhi = min(8, (2047 - (qpos0 - 128)) >> 5);
    nloc = jhi - jlo + 1;
  } else if (MODE == 1) {
    qr = qpos0 >> 6; qc = (qpos0 & 63) + r; rs = min(max(qr - 4, 0), 24); nloc = 16;
  }
  const int ntiles = 8 + nloc;
  auto tile_kb = [&](int i) -> int {
    if (i < 8) return 2048 + i * 32;
    const int j = i - 8;
    if (MODE == 0) return qpos0 - 128 + 32 * (jlo + j);
    return (rs + (j >> 1)) * 64 + 32 * (j & 1);
  };
  const u16* kbase = K + (size_t)r * 64 + h * 8;
  const u16* vbase = Vt + (size_t)r * 2304 + 4 * h;
  s16x8 kf[4];
  {
    const int kb = tile_kb(0);
#pragma unroll
    for (int ks = 0; ks < 4; ++ks) kf[ks] = *(const s16x8*)(kbase + (size_t)kb * 64 + ks * 16);
  }
#pragma unroll 1
  for (int i = 0; i < ntiles; ++i) {
    const int kb = tile_kb(i);
    union { s16x8 v; uint2 u[2]; } v0[2], v1[2];
#pragma unroll
    for (int s2 = 0; s2 < 2; ++s2) {
      const u16* vp0 = vbase + kb + 16 * s2;
      const u16* vp1 = vp0 + (size_t)32 * 2304;
      v0[s2].u[0] = *(const uint2*)vp0; v0[s2].u[1] = *(const uint2*)(vp0 + 8);
      v1[s2].u[0] = *(const uint2*)vp1; v1[s2].u[1] = *(const uint2*)(vp1 + 8);
    }
    s16x8 kn[4];
    {
      const int kbn = tile_kb(i + 1 < ntiles ? i + 1 : i);
#pragma unroll
      for (int ks = 0; ks < 4; ++ks) kn[ks] = *(const s16x8*)(kbase + (size_t)kbn * 64 + ks * 16);
    }
    f32x16 S;
#pragma unroll
    for (int q = 0; q < 16; ++q) S[q] = 0.f;
#pragma unroll
    for (int ks = 0; ks < 4; ++ks) S = MFMA(kf[ks], qf[ks], S);
    if (i >= 8) {
      if (MODE == 0) {
        const int d0 = (qpos0 + r) - (kb + 4 * h);
#pragma unroll
        for (int reg = 0; reg < 16; ++reg) { const int d = d0 - ((reg & 3) + 8 * (reg >> 2)); if (d > 128 || d < -128) S[reg] = -INFINITY; }
      } else if (MODE == 1) {
        const int j = i - 8;
        const float* brow = rpb + ((rs + (j >> 1)) - qr + 7) * 160 + 64;
        const int cstart = min(max(qc - 8, 0), 48);
        const int kc0 = 32 * (j & 1) + 4 * h;
        const float* bp = brow + (kc0 - qc + 15);
        const int rel = kc0 - cstart;
#pragma unroll
        for (int reg = 0; reg < 16; ++reg) {
          const int o = (reg & 3) + 8 * (reg >> 2);
          const bool ok = (unsigned)(rel + o) < 16u;
          S[reg] = ok ? S[reg] + bp[o] : -INFINITY;
        }
      }
    }
    float mx = S[0];
#pragma unroll
    for (int reg = 1; reg < 16; ++reg) mx = fmaxf(mx, S[reg]);
    mx = fmaxf(mx, __shfl_xor(mx, 32));
    const float mnew = fmaxf(mrun, mx);
    const float alpha = __expf(mrun - mnew);
    float ps = 0.f;
#pragma unroll
    for (int reg = 0; reg < 16; ++reg) { S[reg] = __expf(S[reg] - mnew); ps += S[reg]; }
    lrun = lrun * alpha + ps;
    mrun = mnew;
#pragma unroll
    for (int q = 0; q < 16; ++q) { O0[q] *= alpha; O1[q] *= alpha; }
#pragma unroll
    for (int s2 = 0; s2 < 2; ++s2) {
      union { s16x8 v; unsigned u[4]; } pf;
#pragma unroll
      for (int q = 0; q < 4; ++q) pf.u[q] = pack2(S[8 * s2 + 2 * q], S[8 * s2 + 2 * q + 1]);
      O0 = MFMA(v0[s2].v, pf.v, O0);
      O1 = MFMA(v1[s2].v, pf.v, O1);
    }
#pragma unroll
    for (int ks = 0; ks < 4; ++ks) kf[ks] = kn[ks];
  }
  float lt = lrun + __shfl_xor(lrun, 32);
  if (has_sink) lt += __expf(sink - mrun);
  const float inv = 1.f / lt;
  u16* yo = Yout + (size_t)r * 512;
#pragma unroll
  for (int g4 = 0; g4 < 4; ++g4) {
    *(uint2*)(yo + 8 * g4 + 4 * h) = make_uint2(pack2(O0[4 * g4] * inv, O0[4 * g4 + 1] * inv), pack2(O0[4 * g4 + 2] * inv, O0[4 * g4 + 3] * inv));
    *(uint2*)(yo + 32 + 8 * g4 + 4 * h) = make_uint2(pack2(O1[4 * g4] * inv, O1[4 * g4 + 1] * inv), pack2(O1[4 * g4 + 2] * inv, O1[4 * g4 + 3] * inv));
  }
}

constexpr int AT_BUF = 8192 + 64 * 136;
DI void attn_stage_k(const u16* __restrict__ K, int kb, char* buf, int tid) {
#pragma unroll
  for (int i = 0; i < 2; ++i) {
    const int S = tid + NTHR * i, row = S >> 3, c = (S & 7) ^ ((row >> 1) & 7);
    __builtin_amdgcn_global_load_lds((const unsigned*)(K + (size_t)(kb + row) * 64 + c * 8), (__attribute__((address_space(3))) unsigned*)(buf + S * 16), 16, 0, 0);
  }
}
template <int MODE>
DI void attn_block(const u16* __restrict__ Q, const u16* __restrict__ K, const u16* __restrict__ Vt, u16* __restrict__ Yout,
                   int qpos0, int blk_lo, int blk_n, int w_lo, const float* rpb, float sink, bool has_sink, char* lds) {
  const int tid = TIDX, lane = tid & 63, r = lane & 31, h = lane >> 5;
  s16x8 qf[4];
#pragma unroll
  for (int ks = 0; ks < 4; ++ks) qf[ks] = *(const s16x8*)(Q + r * 64 + ks * 16 + h * 8);
  f32x16 O0, O1;
#pragma unroll
  for (int i = 0; i < 16; ++i) { O0[i] = 0.f; O1[i] = 0.f; }
  float mrun = -INFINITY, lrun = 0.f;
  const int nloc = MODE == 0 ? (blk_n + 1) >> 1 : (MODE == 1 ? blk_n : 0);
  const int nst = 4 + nloc;
  auto step_kb = [&](int st) -> int {
    if (st < 4) return 2048 + st * 64;
    return MODE == 0 ? blk_lo + 64 * (st - 4) : (blk_lo + (st - 4)) * 64;
  };
  typedef __attribute__((ext_vector_type(4))) unsigned u32x4;
  const int vd = tid >> 3, vc = (tid & 7) * 8;
  const int kwofs = vd * 128 + (((tid & 7) ^ ((vd >> 1) & 7)) << 4);
  u32x4 kp[2], vp[2], kq[2], vq[2];
  const int sw = (r >> 1) & 7;
  const int qr = qpos0 >> 6, qc = (qpos0 & 63) + r;
#define AT_LOAD(KR, VR, ST) do { const int kb_ = step_kb((ST) < nst ? (ST) : nst - 1); \
    _Pragma("unroll") for (int i = 0; i < 2; ++i) { KR[i] = *(const u32x4*)(K + (size_t)(kb_ + vd + 32 * i) * 64 + vc); \
                                                    VR[i] = *(const u32x4*)(Vt + (size_t)(vd + 32 * i) * 2304 + kb_ + vc); } } while (0)
#define AT_STORE(KR, VR, BUF) do { _Pragma("unroll") for (int i = 0; i < 2; ++i) { *(u32x4*)((BUF) + kwofs + i * 4096) = KR[i]; \
    char* vp_ = (BUF) + 8192 + (vd + 32 * i) * 136 + vc * 2; \
    *(uint2*)vp_ = make_uint2(VR[i][0], VR[i][1]); *(uint2*)(vp_ + 8) = make_uint2(VR[i][2], VR[i][3]); } } while (0)
  auto compute = [&](const int st, const char* cur) {
    const int kb = step_kb(st);
    bool wave_on = true;
    if (MODE == 1 && st >= 4) { const int rr = blk_lo + (st - 4); wave_on = rr >= w_lo && rr < w_lo + 8; }
    if (wave_on) {
#pragma unroll
      for (int th = 0; th < 2; ++th) {
        if (MODE == 0 && st >= 4 && 2 * (st - 4) + th >= blk_n) continue;
        f32x16 S;
#pragma unroll
        for (int q = 0; q < 16; ++q) S[q] = 0.f;
#pragma unroll
        for (int ks = 0; ks < 4; ++ks) {
          const s16x8 kf = *(const s16x8*)(cur + (th * 32 + r) * 128 + (((ks * 2 + h) ^ sw) << 4));
          S = MFMA(kf, qf[ks], S);
        }
        if (st >= 4) {
          if (MODE == 0) {
            const int d0 = (qpos0 + r) - (kb + 32 * th + 4 * h);
#pragma unroll
            for (int reg = 0; reg < 16; ++reg) { const int d = d0 - ((reg & 3) + 8 * (reg >> 2)); if (d > 128 || d < -128) S[reg] = -INFINITY; }
          } else if (MODE == 1) {
            const int rr = blk_lo + (st - 4);
            const float* brow = rpb + (rr - qr + 7) * 160 + 64;
            const int cstart = min(max(qc - 8, 0), 48);
            const int kc0 = 32 * th + 4 * h;
            const float* bp = brow + (kc0 - qc + 15);
            const int rel = kc0 - cstart;
#pragma unroll
            for (int reg = 0; reg < 16; ++reg) {
              const int o = (reg & 3) + 8 * (reg >> 2);
              const bool ok = (unsigned)(rel + o) < 16u;
              const float tb = S[reg] + bp[o];
              S[reg] = ok ? tb : -INFINITY;
            }
          }
        }
        float mx = S[0];
#pragma unroll
        for (int reg = 1; reg < 16; ++reg) mx = fmaxf(mx, S[reg]);
        mx = fmaxf(mx, __shfl_xor(mx, 32));
        const float mnew = fmaxf(mrun, mx);
        const float alpha = __expf(mrun - mnew);
        float ps = 0.f;
#pragma unroll
        for (int reg = 0; reg < 16; ++reg) { S[reg] = __expf(S[reg] - mnew); ps += S[reg]; }
        lrun = lrun * alpha + ps;
        mrun = mnew;
#pragma unroll
        for (int q = 0; q < 16; ++q) { O0[q] *= alpha; O1[q] *= alpha; }
#pragma unroll
        for (int s2 = 0; s2 < 2; ++s2) {
          union { s16x8 v; unsigned u[4]; } pf;
#pragma unroll
          for (int q = 0; q < 4; ++q) pf.u[q] = pack2(S[8 * s2 + 2 * q], S[8 * s2 + 2 * q + 1]);
          union { s16x8 v; uint2 u[2]; } v0, v1;
          const char* vp0 = cur + 8192 + r * 136 + (32 * th + 16 * s2 + 4 * h) * 2;
          const char* vp1 = vp0 + 32 * 136;
          v0.u[0] = *(const uint2*)vp0; v0.u[1] = *(const uint2*)(vp0 + 16);
          v1.u[0] = *(const uint2*)vp1; v1.u[1] = *(const uint2*)(vp1 + 16);
          O0 = MFMA(v0.v, pf.v, O0);
          O1 = MFMA(v1.v, pf.v, O1);
        }
      }
    }
  };
  char* buf0 = lds;
  char* buf1 = lds + AT_BUF;
  AT_LOAD(kp, vp, 0);
  AT_STORE(kp, vp, buf0);
  AT_LOAD(kp, vp, 1);
  __syncthreads();
#pragma unroll 1
  for (int st = 0; st < nst; st += 2) {
    AT_LOAD(kq, vq, st + 2);
    __builtin_amdgcn_sched_barrier(0);
    compute(st, buf0);
    AT_STORE(kp, vp, buf1);
    __syncthreads();
    if (st + 1 < nst) {
      AT_LOAD(kp, vp, st + 3);
      __builtin_amdgcn_sched_barrier(0);
      compute(st + 1, buf1);
      AT_STORE(kq, vq, buf0);
      __syncthreads();
    }
  }
#undef AT_LOAD
#undef AT_STORE
  float lt = lrun + __shfl_xor(lrun, 32);
  if (has_sink) lt += __expf(sink - mrun);
  const float inv = 1.f / lt;
  u16* yo = Yout + (size_t)r * 512;
#pragma unroll
  for (int g4 = 0; g4 < 4; ++g4) {
    *(uint2*)(yo + 8 * g4 + 4 * h) = make_uint2(pack2(O0[4 * g4] * inv, O0[4 * g4 + 1] * inv), pack2(O0[4 * g4 + 2] * inv, O0[4 * g4 + 3] * inv));
    *(uint2*)(yo + 32 + 8 * g4 + 4 * h) = make_uint2(pack2(O1[4 * g4] * inv, O1[4 * g4 + 1] * inv), pack2(O1[4 * g4 + 2] * inv, O1[4 * g4 + 3] * inv));
  }
}

DI void phase_mix(const Params& p, char* wsb, int layer, char* lds) {
  const bool upd = layer < 3;
  const int n_hl = 512, n_swa = 1024, n_na = 1024, n_ca = upd ? 256 : 0, n_hc = upd ? 512 : 0;
  const int total = n_hl + n_swa + n_na + n_ca + n_hc;
  const int wid = TIDX >> 6;
  u16* Y = (u16*)(wsb + OFF_Y);
  const u16* QS = (const u16*)(wsb + OFF_QS);
  const u16* KS = (const u16*)(wsb + OFF_KS);
  const u16* VTS = (const u16*)(wsb + OFF_VTS);
  const u16* QN = (const u16*)(wsb + OFF_QN);
  const u16* KN = (const u16*)(wsb + OFF_KN);
  const u16* VTN = (const u16*)(wsb + OFF_VTN);
  const int nmine = (total - (int)blockIdx.x + (int)gridDim.x - 1) / (int)gridDim.x;
  const bool rev = blockIdx.x >= (gridDim.x >> 1);
#pragma unroll 1
  for (int q = 0; q < nmine; ++q) {
    const int it = (int)blockIdx.x + (rev ? nmine - 1 - q : q) * (int)gridDim.x;
    int t = it;
    __syncthreads();
    if (t < n_hl) { const int ch = (t & 7) * 64 + (t >> 3); REP(9) { __syncthreads(); hyena_item<64>(p, wsb, layer, ch, lds); } continue; }
    t -= n_hl;
    if (t < n_swa) { t = (t & 7) * (n_swa >> 3) + (t >> 3);
      REP(10) {
      const int b = t >> 7, kvh = (t >> 6) & 1, qt = t & 63, head = kvh * 4 + wid;
      const int q0 = qt * 32;
      const int lo = max(q0 - 128, 0), hi = min(q0 + 128, 2016);
      __syncthreads();
      if (!(ATT_NEW & 1)) attn_wave<0>(QS + ((size_t)(b * 8 + head) * 2304 + q0) * 64, KS + (size_t)(b * 2 + kvh) * 2304 * 64, VTS + (size_t)(b * 2 + kvh) * 64 * 2304,
                   Y + ((size_t)1 * TT + (size_t)b * 2048 + q0) * 512 + head * 64, q0, nullptr, p.swa_sink[layer * 8 + head], true);
      else attn_block<0>(QS + ((size_t)(b * 8 + head) * 2304 + q0) * 64, KS + (size_t)(b * 2 + kvh) * 2304 * 64, VTS + (size_t)(b * 2 + kvh) * 64 * 2304,
                    Y + ((size_t)1 * TT + (size_t)b * 2048 + q0) * 512 + head * 64, q0, lo, ((hi - lo) >> 5) + 1, 0, nullptr, p.swa_sink[layer * 8 + head], true, lds); }
      continue;
    }
    t -= n_swa;
    if (t < n_na) { t = (t & 7) * (n_na >> 3) + (t >> 3);
      REP(10) {
      const int b = t >> 7, head = (t >> 4) & 7, rp = t & 15;
      const int row = rp * 2 + (wid >> 1);
      const int q0 = row * 64 + (wid & 1) * 32;
      const int rs0 = min(max(2 * rp - 4, 0), 24), rs1 = min(max(2 * rp + 1 - 4, 0), 24);
      __syncthreads();
      if (!(ATT_NEW & 2)) attn_wave<1>(QN + ((size_t)(b * 8 + head) * 2304 + q0) * 64, KN + (size_t)(b * 8 + head) * 2304 * 64, VTN + (size_t)(b * 8 + head) * 64 * 2304,
                   Y + ((size_t)2 * TT + (size_t)b * 2048 + q0) * 512 + head * 64, q0, (const float*)(wsb + OFF_RPB) + (size_t)(layer * 8 + head) * 15 * 160, 0.f, false);
      else attn_block<1>(QN + ((size_t)(b * 8 + head) * 2304 + q0) * 64, KN + (size_t)(b * 8 + head) * 2304 * 64, VTN + (size_t)(b * 8 + head) * 64 * 2304,
                    Y + ((size_t)2 * TT + (size_t)b * 2048 + q0) * 512 + head * 64, q0, rs0, rs1 - rs0 + 8, min(max(row - 4, 0), 24),
                    (const float*)(wsb + OFF_RPB) + (size_t)(layer * 8 + head) * 15 * 160, 0.f, false, lds); }
      continue;
    }
    t -= n_na;
    if (t < n_ca) {
      const int b = t >> 5, h16 = (t >> 1) & 15, qt = (t & 1) * 4 + wid;
      const int q0 = 2048 + qt * 32;
      if (h16 < 8) {
        const int head = h16, kvh = head >> 2;
        if (!(ATT_NEW & 4)) attn_wave<2>(QS + ((size_t)(b * 8 + head) * 2304 + q0) * 64, KS + (size_t)(b * 2 + kvh) * 2304 * 64, VTS + (size_t)(b * 2 + kvh) * 64 * 2304,
                     Y + ((size_t)1 * TT + (size_t)TL + b * 256 + qt * 32) * 512 + head * 64, 0, nullptr, p.swa_sink[layer * 8 + head], true);
        else attn_block<2>(QS + ((size_t)(b * 8 + head) * 2304 + q0) * 64, KS + (size_t)(b * 2 + kvh) * 2304 * 64, VTS + (size_t)(b * 2 + kvh) * 64 * 2304,
                      Y + ((size_t)1 * TT + (size_t)TL + b * 256 + qt * 32) * 512 + head * 64, 0, 0, 0, 0, nullptr, p.swa_sink[layer * 8 + head], true, lds);
      } else {
        const int head = h16 - 8;
        if (!(ATT_NEW & 4)) attn_wave<2>(QN + ((size_t)(b * 8 + head) * 2304 + q0) * 64, KN + (size_t)(b * 8 + head) * 2304 * 64, VTN + (size_t)(b * 8 + head) * 64 * 2304,
                     Y + ((size_t)2 * TT + (size_t)TL + b * 256 + qt * 32) * 512 + head * 64, 0, nullptr, 0.f, false);
        else attn_block<2>(QN + ((size_t)(b * 8 + head) * 2304 + q0) * 64, KN + (size_t)(b * 8 + head) * 2304 * 64, VTN + (size_t)(b * 8 + head) * 64 * 2304,
                      Y + ((size_t)2 * TT + (size_t)TL + b * 256 + qt * 32) * 512 + head * 64, 0, 0, 0, 0, nullptr, 0.f, false, lds);
      }
      continue;
    }
    t -= n_ca;
    hyena_item<8>(p, wsb, layer, (t & 7) * 64 + (t >> 3), lds);
  }
}

__global__ void __launch_bounds__(NTHR, 2) fwd_megakernel(Params p0) {
  __shared__ __attribute__((aligned(16))) char lds[65536];
  cg::grid_group grid = cg::this_grid();
  __shared__ uint4 xb_words;
  if (threadIdx.x == 0) xb_words = make_uint4(0u, 0u, 0u, 0u);
  __syncthreads();
  const XcdBarrier xb = xcd_barrier_post((unsigned*)(p0.ws + OFF_BAR), (volatile LAS unsigned*)&xb_words);
  REP(8) { unsigned zo = 0; asm volatile("" : "+s"(zo)); char* wsl = p0.ws + zo; phase_prep(p0, wsl, lds); }
  if (p0.out == nullptr) grid.sync();
  xcd_barrier(xb);
  { unsigned zo = 0; asm volatile("" : "+s"(zo)); char* wsl = p0.ws + zo; phase_mods_reduce(p0, wsl); }
  xcd_barrier(xb);
  for (int layer = 0; layer < 4; ++layer) {
    const bool last = layer == 3;
    const int mr2 = last ? TL : TT;
    REP(4) { unsigned zo = 0; asm volatile("" : "+s"(zo)); char* wsl = p0.ws + zo; phase_norm(p0, wsl, layer, 0, TT, true, lds); }
    REP(5) xcd_barrier(xb);
    REP(1) { unsigned zo = 0; asm volatile("" : "+s"(zo)); char* wsl = p0.ws + zo; phase_gu(p0, wsl, 0, TT, lds); }
    REP(5) xcd_barrier(xb);
    { unsigned zo = 0; asm volatile("" : "+s"(zo)); char* wsl = p0.ws + zo; phase_dn(p0, wsl, layer, 0, TT, false, lds); }
    REP(5) xcd_barrier(xb);
    REP(4) { unsigned zo = 0; asm volatile("" : "+s"(zo)); char* wsl = p0.ws + zo; phase_norm(p0, wsl, layer, 1, TT, false, lds); }
    REP(5) xcd_barrier(xb);
    REP(2) { unsigned zo = 0; asm volatile("" : "+s"(zo)); char* wsl = p0.ws + zo; phase_in(p0, wsl, layer, lds); }
    REP(5) xcd_barrier(xb);
    REP(3) { unsigned zo = 0; asm volatile("" : "+s"(zo)); char* wsl = p0.ws + zo; phase_mix(p0, wsl, layer, lds); }
    REP(5) xcd_barrier(xb);
    REP(7) { unsigned zo = 0; asm volatile("" : "+s"(zo)); char* wsl = p0.ws + zo; phase_m1(p0, wsl, mr2, lds); }
    REP(5) xcd_barrier(xb);
    { unsigned zo = 0; asm volatile("" : "+s"(zo)); char* wsl = p0.ws + zo; phase_m2(p0, wsl, layer, mr2, lds); }
    REP(5) xcd_barrier(xb);
    REP(4) { unsigned zo = 0; asm volatile("" : "+s"(zo)); char* wsl = p0.ws + zo; phase_norm(p0, wsl, layer, 2, mr2, false, lds); }
    REP(5) xcd_barrier(xb);
    REP(1) { unsigned zo = 0; asm volatile("" : "+s"(zo)); char* wsl = p0.ws + zo; phase_gu(p0, wsl, 1, mr2, lds); }
    REP(5) xcd_barrier(xb);
    { unsigned zo = 0; asm volatile("" : "+s"(zo)); char* wsl = p0.ws + zo; phase_dn(p0, wsl, layer, 1, mr2, last, lds); }
    if (!last) { REP(5) xcd_barrier(xb); }
  }
}

extern "C" void kernel_launch(void* const* d_in, const int* in_sizes, int n_in, void* d_out, int out_size, void* d_ws,
                              size_t ws_size, hipStream_t stream) {
  static int grid_blocks = 0;
  if (!grid_blocks) {
    int dev = 0, cus = 0, per_cu = 0;
    hipGetDevice(&dev);
    hipDeviceGetAttribute(&cus, hipDeviceAttributeMultiprocessorCount, dev);
    hipOccupancyMaxActiveBlocksPerMultiprocessor(&per_cu, fwd_megakernel, NTHR, 0);
    if (per_cu > 2) per_cu = 2;
    if (per_cu < 1) per_cu = 1;
    grid_blocks = (cus * per_cu) & ~7;
  }
  if (ws_size < WS_NEED) { fprintf(stderr, "workspace too small: %zu < %zu\n", ws_size, WS_NEED); return; }
  Params p{};
  const float** f = (const float**)&p;
  for (int i = 0; i < 30; ++i) f[i] = (const float*)d_in[i];
  p.out = (float*)d_out;
  p.ws = (char*)d_ws;
  hipMemsetAsync(d_ws, 0, 16384, stream);
  void* args[] = {&p};
  hipError_t e = hipLaunchCooperativeKernel((void*)fwd_megakernel, dim3(grid_blocks), dim3(NTHR), args, 0, stream);
  if (e != hipSuccess) fprintf(stderr, "cooperative launch failed: %s (grid %d)\n", hipGetErrorString(e), grid_blocks);
}
```
